# Optimizing an MI355X kernel written in HIP

```python
import math
import jax, jax.numpy as jnp
from jax import lax
import numpy as np

D_MODEL = 1024
BATCH = 4
SEQ = 8192
DEPTH = 2

N_MEM = 256
D_MIX = D_MODEL
D_RWKV = D_MIX // 2
RW_HEAD = 64
RW_HEADS = D_RWKV // RW_HEAD
RW_W_RANK = 64
RW_A_RANK = 64
RW_G_RANK = 128
RW_V_RANK = 32
RW_SPLITS = [D_RWKV, 2 * D_RWKV, 3 * D_RWKV, 3 * D_RWKV + RW_W_RANK, 3 * D_RWKV + RW_W_RANK + RW_A_RANK]
RW_COLS = 3 * D_RWKV + RW_W_RANK + RW_A_RANK + RW_G_RANK
D_S5 = D_MIX - D_RWKV
S5_CH = 16
S5_GROUPS = D_S5 // S5_CH
S5_STATE = 64
D_IN = RW_COLS + D_S5
XA_HEADS = 4
XA_HEAD = D_MODEL // XA_HEADS
PEER_HEADS = 8
PEER_NKEYS = 128
PEER_N = PEER_NKEYS * PEER_NKEYS
PEER_DQ = 256
PEER_DHALF = PEER_DQ // 2
PEER_TOPK = 16
PEER_BLOCK = 128
RMS_EPS = 1e-6
GN_EPS = 64e-5

kernel_name = 'hybrid_rwkv7_s5_peer_memxattn'


def rmsnorm(x, g):
    xf = x.astype(jnp.float32)
    y = xf * lax.rsqrt(jnp.mean(xf * xf, axis=-1, keepdims=True) + RMS_EPS)
    return (y * g.astype(jnp.float32)).astype(x.dtype)


def token_shift(z):
    return jnp.pad(z[:, :-1], ((0, 0), (1, 0), (0, 0)))


def rwkv7_recurrence(r, decay, k, v, a_vec, b_vec):
    bsz, _, nh, n = r.shape

    def step(state, inp):
        r_t, w_t, k_t, v_t, a_t, b_t = inp
        sa = jnp.einsum('bhij,bhj->bhi', state, a_t)
        state = (state * w_t[:, :, None, :] + sa[..., :, None] * b_t[..., None, :]
                 + v_t[..., :, None] * k_t[..., None, :])
        return state, jnp.einsum('bhij,bhj->bhi', state, r_t)

    xs = tuple(jnp.swapaxes(t, 0, 1) for t in (r, decay, k, v, a_vec, b_vec))
    s0 = jnp.zeros((bsz, nh, n, n), jnp.float32)
    _, y = lax.scan(step, s0, xs)
    return jnp.swapaxes(y, 0, 1)


def rwkv7_mix(z, h, mu, w0, w2, a0, a2, g2, k_k, k_a, r_k, lnx_g, lnx_b, v_first, vres):
    f32 = jnp.float32
    bsz, s, _ = z.shape
    z = z + (token_shift(z) - z) * mu
    r, k, v, wd, ad, gd = jnp.split(z, RW_SPLITS, axis=-1)
    w = -jax.nn.softplus(-(w0 + jnp.tanh(wd) @ w2)) - 0.5
    decay = jnp.exp(-jnp.exp(w.astype(f32)))
    if vres is None:
        v_first = v
    else:
        v0, v1, v2 = vres
        v = v + (v_first - v) * jax.nn.sigmoid(v0 + (h @ v1) @ v2)
    a = jax.nn.sigmoid(a0 + ad @ a2)
    g = jax.nn.sigmoid(gd) @ g2

    def heads(t):
        return t.reshape(bsz, s, RW_HEADS, RW_HEAD).astype(f32)

    kk = heads(k * k_k)
    kk = kk / jnp.maximum(jnp.sqrt(jnp.sum(kk * kk, axis=-1, keepdims=True)), 1e-12)
    k = k * (1.0 + (a - 1.0) * k_a)
    rh, kh, vh, ah = heads(r), heads(k), heads(v), heads(a)
    y = rwkv7_recurrence(rh, heads(decay), kh, vh, -kk, kk * ah)
    mean = jnp.mean(y, axis=-1, keepdims=True)
    var = jnp.mean(jnp.square(y - mean), axis=-1, keepdims=True)
    y = ((y - mean) * lax.rsqrt(var + GN_EPS)).reshape(bsz, s, D_RWKV)
    y = y * lnx_g.astype(f32) + lnx_b.astype(f32)
    bonus = jnp.sum(rh * kh * r_k.astype(f32), axis=-1, keepdims=True) * vh
    out = (y + bonus.reshape(bsz, s, D_RWKV)) * g.astype(f32)
    return out.astype(z.dtype), v_first


def complex_affine_combine(e1, e2):
    a1r, a1i, b1r, b1i = e1
    a2r, a2i, b2r, b2i = e2
    ar = a2r * a1r - a2i * a1i
    ai = a2r * a1i + a2i * a1r
    wr, wi = a2r[:, None], a2i[:, None]
    br = wr * b1r - wi * b1i + b2r
    bi = wr * b1i + wi * b1r + b2i
    return ar, ai, br, bi


def s5_mix(u, a_re, a_im, log_dt, b_re, b_im, c_re, c_im, d_skip, glu_w, glu_b, out_g):
    f32 = jnp.float32
    bsz, s, _ = u.shape
    uf = u.astype(f32).reshape(bsz, s, S5_GROUPS, S5_CH)
    lam_re = jnp.minimum(a_re.astype(f32), -1e-4)
    lam_im = a_im.astype(f32)
    dt = jnp.exp(log_dt.astype(f32))[:, None]
    mag = jnp.exp(lam_re * dt)
    lb_re = mag * jnp.cos(lam_im * dt)
    lb_im = mag * jnp.sin(lam_im * dt)
    den = lam_re * lam_re + lam_im * lam_im
    c1_re = ((lb_re - 1.0) * lam_re + lb_im * lam_im) / den
    c1_im = (lb_im * lam_re - (lb_re - 1.0) * lam_im) / den
    br, bi = b_re.astype(f32), b_im.astype(f32)
    bb_re = c1_re[..., None] * br - c1_im[..., None] * bi
    bb_im = c1_re[..., None] * bi + c1_im[..., None] * br
    bu_re = jnp.einsum('bsgc,gpc->sbgp', uf, bb_re)
    bu_im = jnp.einsum('bsgc,gpc->sbgp', uf, bb_im)
    ar_seq = jnp.broadcast_to(lb_re, (s, S5_GROUPS, S5_STATE))
    ai_seq = jnp.broadcast_to(lb_im, (s, S5_GROUPS, S5_STATE))
    _, _, x_re, x_im = lax.associative_scan(complex_affine_combine, (ar_seq, ai_seq, bu_re, bu_im), axis=0)
    y = (jnp.einsum('sbgp,gcp->bsgc', x_re, c_re.astype(f32))
         - jnp.einsum('sbgp,gcp->bsgc', x_im, c_im.astype(f32)))
    y = y.reshape(bsz, s, D_S5) + d_skip.astype(f32) * uf.reshape(bsz, s, D_S5)
    y = jax.nn.gelu(y)
    y = y * jax.nn.sigmoid(y @ glu_w.astype(f32) + glu_b.astype(f32))
    return rmsnorm(y, out_g).astype(u.dtype)


def mem_cross_attention(h, m, wq, wk, wv, wo):
    bsz, s, _ = h.shape
    q = (h @ wq).reshape(bsz, s, XA_HEADS, XA_HEAD)
    k = (m @ wk).reshape(bsz, N_MEM, XA_HEADS, XA_HEAD)
    v = (m @ wv).reshape(bsz, N_MEM, XA_HEADS, XA_HEAD)
    sc = jnp.einsum('bshd,bmhd->bhsm', q, k).astype(jnp.float32) * (XA_HEAD ** -0.5)
    p = jax.nn.softmax(sc, axis=-1).astype(v.dtype)
    o = jnp.einsum('bhsm,bmhd->bshd', p, v).reshape(bsz, s, D_MODEL)
    return o @ wo


def peer_ffn(h, wq, keys, u_tab, v_tab):
    bsz, s, d = h.shape
    hb = h.reshape(-1, PEER_BLOCK, d)

    def block(hc):
        q = (hc @ wq).reshape(PEER_BLOCK, PEER_HEADS, 2, PEER_DHALF)
        sc = jnp.einsum('thcd,hckd->thck', q, keys).astype(jnp.float32)
        s1, i1 = lax.top_k(sc[:, :, 0], PEER_TOPK)
        s2, i2 = lax.top_k(sc[:, :, 1], PEER_TOPK)
        cand = (s1[..., :, None] + s2[..., None, :]).reshape(PEER_BLOCK, PEER_HEADS, PEER_TOPK * PEER_TOPK)
        cidx = (i1[..., :, None] * PEER_NKEYS + i2[..., None, :]).reshape(PEER_BLOCK, PEER_HEADS, PEER_TOPK * PEER_TOPK)
        top, pos = lax.top_k(cand, PEER_TOPK)
        eidx = jnp.take_along_axis(cidx, pos, axis=-1)
        gate = jax.nn.softmax(top, axis=-1)
        ue = jnp.take(u_tab, eidx, axis=0)
        act = jax.nn.gelu(jnp.einsum('thkd,td->thk', ue, hc).astype(jnp.float32))
        ve = jnp.take(v_tab, eidx, axis=0)
        return jnp.einsum('thk,thkd->td', (gate * act).astype(ve.dtype), ve)

    return lax.map(block, hb).reshape(bsz, s, d)


def setup_inputs(seed: int = 0) -> dict:
    key = jax.random.key(seed)
    ks = iter(jax.random.split(key, 48))
    L = DEPTH
    LV = max(DEPTH - 1, 0)
    f32 = jnp.float32

    def nrm(shape, scale):
        return scale * jax.random.normal(next(ks), shape, f32)

    def gain(shape):
        return 1.0 + nrm(shape, 0.02)

    def unif(shape, lo, hi):
        return jax.random.uniform(next(ks), shape, f32, lo, hi)

    n_idx = jnp.arange(S5_STATE, dtype=f32)
    return {
        'x': nrm((BATCH, SEQ, D_MODEL), 1.0),
        'mem': nrm((BATCH, N_MEM, D_MODEL), 1.0),
        'norm_mix': gain((L, D_MODEL)),
        'w_in': nrm((L, D_MODEL, D_IN), D_MODEL ** -0.5),
        'rw_mu': unif((L, RW_COLS), 0.0, 1.0),
        'rw_w0': unif((L, D_RWKV), -6.0, -1.0),
        'rw_w2': nrm((L, RW_W_RANK, D_RWKV), 0.3 * RW_W_RANK ** -0.5),
        'rw_a0': nrm((L, D_RWKV), 0.3),
        'rw_a2': nrm((L, RW_A_RANK, D_RWKV), 0.3 * RW_A_RANK ** -0.5),
        'rw_g2': nrm((L, RW_G_RANK, D_RWKV), RW_G_RANK ** -0.5),
        'rw_kk': 0.85 + nrm((L, D_RWKV), 0.02),
        'rw_ka': gain((L, D_RWKV)),
        'rw_rk': nrm((L, RW_HEADS, RW_HEAD), 0.1),
        'rw_v0': 1.0 + nrm((LV, D_RWKV), 0.1),
        'rw_v1': nrm((LV, D_MODEL, RW_V_RANK), D_MODEL ** -0.5),
        'rw_v2': nrm((LV, RW_V_RANK, D_RWKV), 0.3 * RW_V_RANK ** -0.5),
        'rw_lnx_g': gain((L, D_RWKV)),
        'rw_lnx_b': nrm((L, D_RWKV), 0.01),
        's5_a_re': -0.5 + nrm((L, S5_GROUPS, S5_STATE), 0.01),
        's5_a_im': math.pi * n_idx + nrm((L, S5_GROUPS, S5_STATE), 0.01),
        's5_log_dt': unif((L, S5_GROUPS), math.log(1e-3), math.log(1e-1)),
        's5_b_re': nrm((L, S5_GROUPS, S5_STATE, S5_CH), (2 * S5_CH) ** -0.5),
        's5_b_im': nrm((L, S5_GROUPS, S5_STATE, S5_CH), (2 * S5_CH) ** -0.5),
        's5_c_re': nrm((L, S5_GROUPS, S5_CH, S5_STATE), S5_STATE ** -0.5),
        's5_c_im': nrm((L, S5_GROUPS, S5_CH, S5_STATE), S5_STATE ** -0.5),
        's5_d': nrm((L, D_S5), 1.0),
        's5_glu_w': nrm((L, D_S5, D_S5), D_S5 ** -0.5),
        's5_glu_b': nrm((L, D_S5), 0.01),
        's5_out_g': gain((L, D_S5)),
        'w_out': nrm((L, D_MIX, D_MODEL), D_MIX ** -0.5),
        'norm_xa': gain((L, D_MODEL)),
        'norm_mem': gain((L, D_MODEL)),
        'xa_wq': nrm((L, D_MODEL, D_MODEL), D_MODEL ** -0.5),
        'xa_wk': nrm((L, D_MODEL, D_MODEL), D_MODEL ** -0.5),
        'xa_wv': nrm((L, D_MODEL, D_MODEL), D_MODEL ** -0.5),
        'xa_wo': nrm((L, D_MODEL, D_MODEL), D_MODEL ** -0.5),
        'norm_ffn': gain((L, D_MODEL)),
        'peer_wq': nrm((L, D_MODEL, PEER_HEADS * PEER_DQ), D_MODEL ** -0.5),
        'peer_keys': nrm((L, PEER_HEADS, 2, PEER_NKEYS, PEER_DHALF), PEER_DHALF ** -0.5),
        'peer_u': nrm((L, PEER_N, D_MODEL), D_MODEL ** -0.5),
        'peer_v': nrm((L, PEER_N, D_MODEL), PEER_HEADS ** -0.5),
        'norm_final': gain((D_MODEL,)),
    }


def reference(x, mem, norm_mix, w_in, rw_mu, rw_w0, rw_w2, rw_a0, rw_a2, rw_g2, rw_kk, rw_ka, rw_rk,
              rw_v0, rw_v1, rw_v2, rw_lnx_g, rw_lnx_b, s5_a_re, s5_a_im, s5_log_dt, s5_b_re, s5_b_im,
              s5_c_re, s5_c_im, s5_d, s5_glu_w, s5_glu_b, s5_out_g, w_out, norm_xa, norm_mem,
              xa_wq, xa_wk, xa_wv, xa_wo, norm_ffn, peer_wq, peer_keys, peer_u, peer_v, norm_final):
    v_first = None
    for l in range(DEPTH):
        h = rmsnorm(x, norm_mix[l])
        z = h @ w_in[l]
        z_rw, u_s5 = z[..., :RW_COLS], z[..., RW_COLS:]
        vres = None if l == 0 else (rw_v0[l - 1], rw_v1[l - 1], rw_v2[l - 1])
        y_rw, v_first = rwkv7_mix(z_rw, h, rw_mu[l], rw_w0[l], rw_w2[l], rw_a0[l], rw_a2[l], rw_g2[l],
                                  rw_kk[l], rw_ka[l], rw_rk[l], rw_lnx_g[l], rw_lnx_b[l], v_first, vres)
        y_s5 = s5_mix(u_s5, s5_a_re[l], s5_a_im[l], s5_log_dt[l], s5_b_re[l], s5_b_im[l],
                      s5_c_re[l], s5_c_im[l], s5_d[l], s5_glu_w[l], s5_glu_b[l], s5_out_g[l])
        x = x + jnp.concatenate([y_rw, y_s5], axis=-1) @ w_out[l]
        x = x + mem_cross_attention(rmsnorm(x, norm_xa[l]), rmsnorm(mem, norm_mem[l]),
                                    xa_wq[l], xa_wk[l], xa_wv[l], xa_wo[l])
        x = x + peer_ffn(rmsnorm(x, norm_ffn[l]), peer_wq[l], peer_keys[l], peer_u[l], peer_v[l])
    return rmsnorm(x, norm_final)
```

```cpp
#include <hip/hip_runtime.h>
#include <hip/hip_bf16.h>
#include <cstdio>
#include <cstdint>

#define NTHREADS 512
#ifndef PROBE
#define PROBE 0
#endif
#define LAS __attribute__((address_space(3)))
typedef unsigned short bf16_t;
typedef LAS unsigned char* ldsp;
using bf16x8 = __attribute__((ext_vector_type(8))) short;
using f32x16 = __attribute__((ext_vector_type(16))) float;
using f32x4  = __attribute__((ext_vector_type(4))) float;
using u32x4  = __attribute__((ext_vector_type(4))) unsigned;
using i32x4  = __attribute__((ext_vector_type(4))) int;
using i32x16 = __attribute__((ext_vector_type(16))) int;

constexpr int T_TOK = 32768, SEQ = 8192, NB = 4, DM = 1024, NL = 2;
constexpr int ZC = 2368;
constexpr int ZN0 = 2304, ZN1 = 2336;
constexpr int NCH = 128;
constexpr float RMS_EPS = 1e-6f, GN_EPS = 64e-5f;
constexpr int LDS_TOTAL = 163840;
constexpr int LDS_ST = LDS_TOTAL - 16;
constexpr int LDS_RSL = LDS_TOTAL - 1024;
constexpr int L_SXL = LDS_TOTAL - 2560;
constexpr int L_SAL = LDS_TOTAL - 3072;

enum { I_X = 0, I_MEM, I_NORM_MIX, I_W_IN, I_MU, I_W0, I_W2, I_A0, I_A2, I_G2, I_KK, I_KA, I_RK, I_V0, I_V1, I_V2, I_LNG, I_LNB,
       I_S5ARE, I_S5AIM, I_S5DT, I_S5BRE, I_S5BIM, I_S5CRE, I_S5CIM, I_S5D, I_GLUW, I_GLUB, I_S5OG, I_WOUT, I_NXA, I_NMEM,
       I_WQ, I_WK, I_WV, I_WO, I_NFFN, I_PWQ, I_PKEYS, I_PU, I_PV, I_NFIN, N_IN };

constexpr size_t al256(size_t x) { return (x + 255) & ~(size_t)255; }
constexpr size_t WS_CTL   = 0;
constexpr size_t WS_WT    = 65536;
constexpr size_t WO_WIN   = 0;
constexpr size_t WO_GLU   = WO_WIN  + (size_t)2560 * 1024 * 2;
constexpr size_t WO_WOUT  = WO_GLU  + (size_t)512 * 512 * 2;
constexpr size_t WO_WQ    = WO_WOUT + (size_t)1024 * 1024 * 2;
constexpr size_t WO_WK    = WO_WQ   + (size_t)1024 * 1024 * 2;
constexpr size_t WO_WV    = WO_WK   + (size_t)1024 * 1024 * 2;
constexpr size_t WO_WO    = WO_WV   + (size_t)1024 * 1024 * 2;
constexpr size_t WO_WPQ   = WO_WO   + (size_t)1024 * 1024 * 2;
constexpr size_t WO_KEYS  = WO_WPQ  + (size_t)2048 * 1024 * 2;
constexpr size_t WO_W2T   = WO_KEYS + (size_t)16 * 128 * 128 * 2;
constexpr size_t WO_A2T   = WO_W2T  + (size_t)512 * 64 * 2;
constexpr size_t WO_G2T   = WO_A2T  + (size_t)512 * 64 * 2;
constexpr size_t WO_V2T   = WO_G2T  + (size_t)512 * 128 * 2;
constexpr size_t WO_BBAR  = WO_V2T  + (size_t)512 * 32 * 2;
constexpr size_t WO_LAM   = WO_BBAR + (size_t)32 * 64 * 32 * 4;
constexpr size_t WO_CMAT  = WO_LAM  + (size_t)32 * 64 * 4 * 4;
constexpr size_t WO_SU    = WO_CMAT + (size_t)32 * 16 * 128 * 2;
constexpr size_t WO_SV    = WO_SU + (size_t)16384 * 4;
constexpr size_t WO_BB2   = WO_SV + (size_t)16384 * 4;
constexpr size_t WO_SW    = WO_BB2 + (size_t)32 * 128 * 16 * 2;
constexpr int SW_WIN = 0, SW_WOUT = 2560, SW_WQ = 3584, SW_WO = 4608, SW_WPQ = 5632, SW_TOTAL = 7680;
constexpr size_t WT_LAYER = al256(WO_SW + (size_t)SW_TOTAL * 4);
constexpr size_t WS_MEMB  = WS_WT + NL * WT_LAYER;
constexpr size_t WS_KMEM  = WS_MEMB + (size_t)1024 * 1024 * 2;
constexpr size_t WS_VMEMT = WS_KMEM + (size_t)NL * 1024 * 1024 * 2;
constexpr size_t WS_RS    = WS_VMEMT + (size_t)NL * 1024 * 1024 * 2;
constexpr size_t WS_UB    = WS_RS + (size_t)T_TOK * 4;
constexpr size_t WS_VB    = WS_UB + (size_t)NL * 16384 * 1024;
constexpr size_t WS_XB    = WS_VB + (size_t)NL * 16384 * 1024;
constexpr size_t WS_XQ    = WS_XB;
constexpr size_t WS_SX    = WS_XQ + (size_t)T_TOK * 1024;
constexpr size_t WS_W8    = al256(WS_SX + (size_t)T_TOK * 4);
constexpr size_t W8_WIN = 0, W8_WQ = (size_t)5 * 524288, W8_WO = W8_WQ + (size_t)2 * 524288, W8_WPQ = W8_WO + (size_t)2 * 524288, W8_LAYER = W8_WPQ + (size_t)4 * 524288;
static_assert(WS_W8 + NL * W8_LAYER <= WS_XB + (size_t)T_TOK * 1024 * 2, "tiled int8 weights overflow the XB region");
constexpr size_t WS_Z     = WS_XB + (size_t)T_TOK * 1024 * 2;
constexpr size_t WS_YMIX  = WS_Z + (size_t)T_TOK * ZC * 2;
constexpr size_t WS_VFIRST= WS_YMIX + (size_t)T_TOK * 1024 * 2;
constexpr size_t WS_SCR   = WS_VFIRST + (size_t)T_TOK * 512 * 2;
constexpr size_t SCR_BLK  = 327680;
constexpr size_t WS_END   = WS_SCR + (size_t)256 * SCR_BLK;

typedef __bf16 bf2_t __attribute__((ext_vector_type(2)));
__device__ __forceinline__ bf16_t f2bf(float f) { return __builtin_bit_cast(unsigned short, (__bf16)f); }
__device__ __forceinline__ float bf2f(bf16_t h) { return __uint_as_float((unsigned)h << 16); }
__device__ __forceinline__ float bflo(unsigned w) { return __uint_as_float(w << 16); }
__device__ __forceinline__ float bfhi(unsigned w) { return __uint_as_float(w & 0xffff0000u); }
__device__ __forceinline__ unsigned pack2(float a, float b) { bf2_t v; v[0] = (__bf16)a; v[1] = (__bf16)b; return __builtin_bit_cast(unsigned, v); }
__device__ __forceinline__ void unpack8(const u32x4 w, float* f) { f[0] = bflo(w[0]); f[1] = bfhi(w[0]); f[2] = bflo(w[1]); f[3] = bfhi(w[1]); f[4] = bflo(w[2]); f[5] = bfhi(w[2]); f[6] = bflo(w[3]); f[7] = bfhi(w[3]); }
__device__ __forceinline__ float rcp_(float x) { return __builtin_amdgcn_rcpf(x); }
__device__ __forceinline__ float sigmoidf_(float x) { return rcp_(1.0f + __expf(-x)); }
__device__ __forceinline__ float tanh_(float y) { return 1.0f - 2.0f * rcp_(__expf(2.0f * y) + 1.0f); }
__device__ __forceinline__ float gelu_(float x) { return 0.5f * x * (1.0f + tanh_(0.7978845608028654f * (x + 0.044715f * x * x * x))); }
__device__ __forceinline__ float softplus_(float x) { return fmaxf(x, 0.f) + __logf(1.0f + __expf(-fabsf(x))); }

template <int C> __device__ __forceinline__ float dppf(float v) {
    return __int_as_float(__builtin_amdgcn_update_dpp(__float_as_int(v), __float_as_int(v), C, 0xf, 0xf, false));
}
__device__ __forceinline__ float row16_sum(float v) { v += dppf<0xB1>(v); v += dppf<0x4E>(v); v += dppf<0x141>(v); v += dppf<0x140>(v); return v; }
__device__ __forceinline__ float row16_max(float v) { v = fmaxf(v, dppf<0xB1>(v)); v = fmaxf(v, dppf<0x4E>(v)); v = fmaxf(v, dppf<0x141>(v)); v = fmaxf(v, dppf<0x140>(v)); return v; }
__device__ __forceinline__ float grp8_sum(float v) { v += dppf<0xB1>(v); v += dppf<0x4E>(v); v += dppf<0x141>(v); return v; }
__device__ __forceinline__ float rl(float v, int l) { return __int_as_float(__builtin_amdgcn_readlane(__float_as_int(v), l)); }
__device__ __forceinline__ float wave_sum(float v) { v = row16_sum(v); return (rl(v, 0) + rl(v, 16)) + (rl(v, 32) + rl(v, 48)); }
template <int C> __device__ __forceinline__ int dppi(int v) { return __builtin_amdgcn_update_dpp(v, v, C, 0xf, 0xf, false); }
__device__ __forceinline__ int wave_sum_i(int v) {
    v += dppi<0xB1>(v); v += dppi<0x4E>(v); v += dppi<0x141>(v); v += dppi<0x140>(v);
    return (__builtin_amdgcn_readlane(v, 0) + __builtin_amdgcn_readlane(v, 16)) + (__builtin_amdgcn_readlane(v, 32) + __builtin_amdgcn_readlane(v, 48));
}
__device__ __forceinline__ int row16_sum_i(int v) { v += dppi<0xB1>(v); v += dppi<0x4E>(v); v += dppi<0x141>(v); v += dppi<0x140>(v); return v; }
__device__ __forceinline__ float wave_max(float v) { v = row16_max(v); return fmaxf(fmaxf(rl(v, 0), rl(v, 16)), fmaxf(rl(v, 32), rl(v, 48))); }

#define XB_TMO      128
#define XB_XCNT(j)  (256  + 64 * (j))
#define XB_XSUB(j)  (1280 + 64 * (j))
#define XB_XGEN(j)  (2304 + 64 * (j))
#define XB_TOP      3328
#define XB_TOPGEN   3392
#define XCD_BAR_WORDS 3456
#define XB_SPIN_CAP (1u << 24)
__device__ __forceinline__ unsigned xb_ld(unsigned* p)              { return __hip_atomic_load(p, __ATOMIC_RELAXED, __HIP_MEMORY_SCOPE_AGENT); }
__device__ __forceinline__ unsigned xb_add(unsigned* p, unsigned v) { return __hip_atomic_fetch_add(p, v, __ATOMIC_RELAXED, __HIP_MEMORY_SCOPE_AGENT); }
__device__ __forceinline__ unsigned xb_xcc_id() { return (unsigned)__builtin_amdgcn_s_getreg((3 << 11) | 20) & 0xFu; }
#define XB_SPIN(cond, bar) do { unsigned _sp = 0; while (cond) { __builtin_amdgcn_s_sleep(1); \
    if ((++_sp & 255u) == 0u) { if (xb_ld(&(bar)[XB_TMO])) break; if (_sp > XB_SPIN_CAP) { atomicAdd(&(bar)[XB_TMO], 1u); break; } } } } while (0)
struct XcdBarrier { unsigned* bar; unsigned x; volatile LAS unsigned* st; };
__device__ __forceinline__ XcdBarrier xcd_barrier_post(unsigned* bar, volatile LAS unsigned* st) {
    XcdBarrier b; b.bar = bar; b.x = xb_xcc_id(); b.st = st;
    if (threadIdx.x == 0) (void)xb_add(&bar[XB_XCNT(b.x)], 1u);
    return b;
}
__device__ __forceinline__ void xcd_barrier_complete(unsigned* bar, unsigned x, unsigned& nloc, unsigned& nx) {
    const unsigned G = gridDim.x * gridDim.y * gridDim.z;
    unsigned sum, cnt, mine, sp = 0u;
    for (;;) {
        sum = 0u; cnt = 0u; mine = 0u;
#pragma unroll
        for (unsigned j = 0; j < 16; ++j) { const unsigned c = xb_ld(&bar[XB_XCNT(j)]); sum += c; cnt += (c > 0u) ? 1u : 0u; mine = (j == x) ? c : mine; }
        if (sum == G) break;
        __builtin_amdgcn_s_sleep(1);
        if ((++sp & 255u) == 0u) { if (xb_ld(&bar[XB_TMO])) break; if (sp > XB_SPIN_CAP) { atomicAdd(&bar[XB_TMO], 1u); break; } }
    }
    nloc = mine > 0u ? mine : 1u; nx = cnt > 0u ? cnt : 1u;
}
__device__ __forceinline__ void xcd_barrier(const XcdBarrier& b) {
    asm volatile("s_waitcnt vmcnt(0)" ::: "memory");
    __syncthreads();
    if (threadIdx.x == 0) {
        unsigned* bar = b.bar;
        __builtin_amdgcn_s_waitcnt(0);
        unsigned nloc = b.st[0], nx = b.st[1];
        if (nloc == 0u) { xcd_barrier_complete(bar, b.x, nloc, nx); b.st[0] = nloc; b.st[1] = nx; }
        const unsigned old = xb_add(&bar[XB_XSUB(b.x)], 1u);
        const unsigned gen = old / nloc;
        if (old + 1u == (gen + 1u) * nloc) {
            __builtin_amdgcn_fence(__ATOMIC_RELEASE, "agent");
            asm volatile("s_waitcnt vmcnt(0)" ::: "memory");
            const unsigned og = xb_add(&bar[XB_TOP], 1u);
            const unsigned tg = og / nx;
            if (og + 1u == (tg + 1u) * nx) xb_add(&bar[XB_TOPGEN], 1u);
            else XB_SPIN(xb_ld(&bar[XB_TOPGEN]) == tg, bar);
            __builtin_amdgcn_fence(__ATOMIC_ACQUIRE, "agent");
            xb_add(&bar[XB_XGEN(b.x)], 1u);
            asm volatile("s_waitcnt vmcnt(0)" ::: "memory");
        } else {
            XB_SPIN(xb_ld(&bar[XB_XGEN(b.x)]) == gen, bar);
            __builtin_amdgcn_fence(__ATOMIC_ACQUIRE, "agent");
            asm volatile("s_waitcnt vmcnt(0)" ::: "memory");
        }
    }
    __syncthreads();
}

struct Params {
    const float* in[N_IN];
    float* out;
    unsigned char* ws;
    int ph_lo, ph_hi;
};

__device__ __forceinline__ int tid_opaque() { int t = threadIdx.x; asm volatile("" : "+v"(t)); return t; }
__device__ __forceinline__ int bid_opaque() { int b = __builtin_amdgcn_readfirstlane(blockIdx.x); asm volatile("" : "+s"(b)); return b; }
__device__ __forceinline__ unsigned char* ptr_opaque(unsigned char* ptr) {
    unsigned lo = __builtin_amdgcn_readfirstlane((unsigned)(unsigned long long)ptr), hi = __builtin_amdgcn_readfirstlane((unsigned)((unsigned long long)ptr >> 32));
    asm volatile("" : "+s"(lo), "+s"(hi));
    typedef __attribute__((address_space(1))) unsigned char* gptr_t;
    unsigned char* r = (unsigned char*)(gptr_t)(((unsigned long long)hi << 32) | lo);
    return r;
}
__device__ __forceinline__ void block_gsync() { asm volatile("s_waitcnt vmcnt(0)" ::: "memory"); __syncthreads(); }

__device__ __forceinline__ int swz(int row, int slot) { return row * 128 + (((slot ^ (row >> 1)) & 7) << 4); }

template <int BN>
__device__ __forceinline__ void gemm_to_lds(const bf16_t* __restrict__ A, int lda, const bf16_t* __restrict__ Bt, int ldb, int K, ldsp lds) {
    constexpr int NI = BN / 128;
    constexpr int BCH = BN / 64;
    constexpr int STAGE = 16384 + BN * 128;
    constexpr int TS = (BN == 128) ? 129 : BN + 4;
    int tid = threadIdx.x;
    asm volatile("" : "+v"(tid));
    const int lane = tid & 63, wave = tid >> 6;
    const int wvu = __builtin_amdgcn_readfirstlane(wave);
    const int wm = wave >> 2, wn = wave & 3;
    const int fr = lane & 31, fh = lane >> 5;
    f32x16 acc[2][NI];
#pragma unroll
    for (int mi = 0; mi < 2; ++mi)
#pragma unroll
        for (int ni = 0; ni < NI; ++ni)
#pragma unroll
            for (int r = 0; r < 16; ++r) acc[mi][ni][r] = 0.f;
    const int crow = tid >> 3;
    const int lslot = (tid & 7) ^ ((crow >> 1) & 7);
    const bf16_t* Ag = A + (size_t)crow * lda + lslot * 8;
    const bf16_t* Bg = Bt + (size_t)crow * ldb + lslot * 8;
    unsigned char* ldg = (unsigned char*)lds;
    const int nk = K >> 6;
#define GEMM_ISSUE(kt_, st_) do { \
        _Pragma("unroll") for (int j = 0; j < 2; ++j) \
            __builtin_amdgcn_global_load_lds((const unsigned*)(Ag + (size_t)(64 * j) * lda + (kt_) * 64), (LAS unsigned*)(lds + (st_) * STAGE + j * 8192 + wvu * 1024), 16, 0, 0); \
        _Pragma("unroll") for (int j = 0; j < BCH; ++j) \
            __builtin_amdgcn_global_load_lds((const unsigned*)(Bg + (size_t)(64 * j) * ldb + (kt_) * 64), (LAS unsigned*)(lds + (st_) * STAGE + 16384 + j * 8192 + wvu * 1024), 16, 0, 0); \
    } while (0)
    (void)ldg;
    GEMM_ISSUE(0, 0);
    if (nk > 1) GEMM_ISSUE(1, 1);
    int st = 0;
#pragma unroll 1
    for (int kt = 0; kt < nk; ++kt) {
        if (kt + 1 < nk) { if constexpr (BN == 256) asm volatile("s_waitcnt vmcnt(6)" ::: "memory"); else asm volatile("s_waitcnt vmcnt(4)" ::: "memory"); }
        else asm volatile("s_waitcnt vmcnt(0)" ::: "memory");
        asm volatile("s_waitcnt lgkmcnt(0)" ::: "memory");
        __builtin_amdgcn_s_barrier();
        ldsp base = lds + st * STAGE;
        bf16x8 a[4][2], b[4][NI];
#pragma unroll
        for (int kk = 0; kk < 4; ++kk) {
#pragma unroll
            for (int mi = 0; mi < 2; ++mi) a[kk][mi] = *(LAS bf16x8*)(base + swz(wm * 64 + mi * 32 + fr, kk * 2 + fh));
#pragma unroll
            for (int ni = 0; ni < NI; ++ni) b[kk][ni] = *(LAS bf16x8*)(base + 16384 + swz(wn * (BN / 4) + ni * 32 + fr, kk * 2 + fh));
        }
        if (kt + 2 < nk) { const int s2 = (st == 0) ? 2 : st - 1; GEMM_ISSUE(kt + 2, s2); }
#pragma unroll
        for (int kk = 0; kk < 4; ++kk)
#pragma unroll
            for (int mi = 0; mi < 2; ++mi)
#pragma unroll
                for (int ni = 0; ni < NI; ++ni) acc[mi][ni] = __builtin_amdgcn_mfma_f32_32x32x16_bf16(a[kk][mi], b[kk][ni], acc[mi][ni], 0, 0, 0);
        st = (st == 2) ? 0 : st + 1;
    }
#undef GEMM_ISSUE
    asm volatile("s_waitcnt lgkmcnt(0)" ::: "memory");
    __builtin_amdgcn_s_barrier();
    LAS float* tile = (LAS float*)lds;
#pragma unroll
    for (int mi = 0; mi < 2; ++mi)
#pragma unroll
        for (int ni = 0; ni < NI; ++ni) {
            LAS float* tp = tile + (wm * 64 + mi * 32 + 4 * fh) * TS + wn * (BN / 4) + ni * 32 + fr;
#pragma unroll
            for (int r = 0; r < 16; ++r) tp[((r & 3) + 8 * (r >> 2)) * TS] = acc[mi][ni][r];
        }
    __syncthreads();
}

__device__ __forceinline__ int swz4(int row, int slot) { return row * 64 + (((slot ^ (row >> 2)) & 3) << 4); }
template <bool I8> struct AccSel { using T = f32x16; };
template <> struct AccSel<true> { using T = i32x16; };
template <bool I8>
__device__ __forceinline__ void gemm512_acc(const unsigned char* __restrict__ A, int lda, const unsigned char* __restrict__ Bt, int ldb, int kst, int KB, ldsp lds, typename AccSel<I8>::T (&acc)[2][4]) {
    constexpr int BST = 32768, AST = 8192, AOFF = 4 * BST;
    int tid = threadIdx.x;
    asm volatile("" : "+v"(tid));
    const int lane = tid & 63, wave = tid >> 6;
    const int wvu = __builtin_amdgcn_readfirstlane(wave);
    const int wm = wave >> 2, wn = wave & 3;
    const int fr = lane & 31, fh = lane >> 5;
#pragma unroll
    for (int mi = 0; mi < 2; ++mi)
#pragma unroll
        for (int ni = 0; ni < 4; ++ni)
#pragma unroll
            for (int r = 0; r < 16; ++r) acc[mi][ni][r] = 0;
    const int drow = wvu * 16 + (lane >> 2);
    const int lslot = (lane & 3) ^ ((drow >> 2) & 3);
    const unsigned char* Ag = A + (size_t)drow * lda + lslot * 16;
    const unsigned char* Bg = Bt + (size_t)drow * ldb + lslot * 16;
    const int nk = KB >> 6;
#define G5_ISSUE_A(kt_, sa_) __builtin_amdgcn_global_load_lds((const unsigned*)(Ag + (kt_) * 64), (LAS unsigned*)(lds + AOFF + (sa_) * AST + wvu * 1024), 16, 0, 0)
#define G5_ISSUE_B(kt_, sb_) do { _Pragma("unroll") for (int j = 0; j < 4; ++j) \
            __builtin_amdgcn_global_load_lds((const unsigned*)(Bg + (size_t)(128 * j) * ldb + (size_t)(kt_) * kst), (LAS unsigned*)(lds + (sb_) * BST + j * 8192 + wvu * 1024), 16, 0, 0); } while (0)
    G5_ISSUE_B(0, 0); G5_ISSUE_A(0, 0); G5_ISSUE_B(1, 1); G5_ISSUE_A(1, 1); G5_ISSUE_B(2, 2);
    int sa = 0;
#pragma unroll 1
    for (int kt = 0; kt < nk; ++kt) {
        if (kt + 2 < nk) asm volatile("s_waitcnt vmcnt(9)" ::: "memory");
        else if (kt + 1 < nk) asm volatile("s_waitcnt vmcnt(5)" ::: "memory");
        else asm volatile("s_waitcnt vmcnt(0)" ::: "memory");
        asm volatile("s_waitcnt lgkmcnt(0)" ::: "memory");
        __builtin_amdgcn_s_barrier();
        ldsp baseA = lds + AOFF + sa * AST;
        ldsp baseB = lds + (kt & 3) * BST;
        bf16x8 a[2][2], b[2][4];
#pragma unroll
        for (int kk = 0; kk < 2; ++kk) {
#pragma unroll
            for (int mi = 0; mi < 2; ++mi) a[kk][mi] = *(LAS bf16x8*)(baseA + swz4(wm * 64 + mi * 32 + fr, kk * 2 + fh));
#pragma unroll
            for (int ni = 0; ni < 4; ++ni) b[kk][ni] = *(LAS bf16x8*)(baseB + swz4((ni >> 1) * 256 + wn * 64 + (ni & 1) * 32 + fr, kk * 2 + fh));
        }
        if (kt + 2 < nk) G5_ISSUE_A(kt + 2, (sa == 0) ? 2 : sa - 1);
        if (kt + 3 < nk) G5_ISSUE_B(kt + 3, (kt + 3) & 3);
#pragma unroll
        for (int kk = 0; kk < 2; ++kk)
#pragma unroll
            for (int mi = 0; mi < 2; ++mi)
#pragma unroll
                for (int ni = 0; ni < 4; ++ni) {
                    if constexpr (I8) acc[mi][ni] = __builtin_amdgcn_mfma_i32_32x32x32_i8(__builtin_bit_cast(i32x4, a[kk][mi]), __builtin_bit_cast(i32x4, b[kk][ni]), acc[mi][ni], 0, 0, 0);
                    else acc[mi][ni] = __builtin_amdgcn_mfma_f32_32x32x16_bf16(a[kk][mi], b[kk][ni], acc[mi][ni], 0, 0, 0);
                }
        sa = (sa == 2) ? 0 : sa + 1;
    }
#undef G5_ISSUE_A
#undef G5_ISSUE_B
    asm volatile("s_waitcnt lgkmcnt(0)" ::: "memory");
    __builtin_amdgcn_s_barrier();
}
template <class ACC>
__device__ __forceinline__ void gemm512_store_half(const ACC (&acc)[2][4], int h, ldsp lds) {
    int tid = threadIdx.x;
    asm volatile("" : "+v"(tid));
    const int lane = tid & 63, wave = tid >> 6, wm = wave >> 2, wn = wave & 3, fr = lane & 31, fh = lane >> 5;
    using el_t = decltype(acc[0][0][0] + 0);
    LAS el_t* tile = (LAS el_t*)lds;
#pragma unroll
    for (int mi = 0; mi < 2; ++mi)
#pragma unroll
        for (int n2 = 0; n2 < 2; ++n2) {
            LAS el_t* tp = tile + (wm * 64 + mi * 32 + 4 * fh) * 260 + wn * 64 + n2 * 32 + fr;
#pragma unroll
            for (int r = 0; r < 16; ++r) tp[((r & 3) + 8 * (r >> 2)) * 260] = (h == 0) ? acc[mi][n2][r] : acc[mi][2 + n2][r];
        }
    __syncthreads();
}

template <class Epi>
__device__ __forceinline__ void lds_mm64(ldsp A, int lda, ldsp B, int ldb, int K, Epi epi) {
    const int tid = threadIdx.x, lane = tid & 63, wave = tid >> 6;
    if (wave < 4) {
        const int mi = wave >> 1, ni = wave & 1, fr = lane & 31, fh = lane >> 5;
        f32x16 acc;
#pragma unroll
        for (int r = 0; r < 16; ++r) acc[r] = 0.f;
        for (int kk = 0; kk < (K >> 4); ++kk) {
            bf16x8 a = *(LAS bf16x8*)(A + (mi * 32 + fr) * lda + (kk * 16 + fh * 8) * 2);
            bf16x8 b = *(LAS bf16x8*)(B + (ni * 32 + fr) * ldb + (kk * 16 + fh * 8) * 2);
            acc = __builtin_amdgcn_mfma_f32_32x32x16_bf16(a, b, acc, 0, 0, 0);
        }
#pragma unroll
        for (int r = 0; r < 16; ++r) epi(mi * 32 + (r & 3) + 8 * (r >> 2) + 4 * fh, ni * 32 + fr, acc[r]);
    }
}

struct TMat { const float* src; const float* gain; bf16_t* dst; int K, N, ld_src, ld_dst; };

__device__ __forceinline__ unsigned char* wt_layer(const Params& p, int l) { return p.ws + WS_WT + (size_t)l * WT_LAYER; }

__device__ void p0_transposes(const Params& p, ldsp lds) {
    const int tid = tid_opaque(), G = gridDim.x, bid = bid_opaque();
    TMat* tab = (TMat*)(unsigned char*)(lds + 32768);
    int* pre = (int*)(unsigned char*)(lds + 32768 + 4096);
    constexpr int NMAT = 27;
    if (tid == 0) {
        int n = 0;
        for (int l = 0; l < NL; ++l) {
            unsigned char* W = wt_layer(p, l);
            auto add = [&](const float* s, const float* g, size_t off, int K, int N, int ldd) { TMat m; m.src = s; m.gain = g; m.dst = (bf16_t*)(W + off); m.K = K; m.N = N; m.ld_src = N; m.ld_dst = ldd; tab[n++] = m; };
            add(p.in[I_W_IN] + (size_t)l * 1024 * 2304, p.in[I_NORM_MIX] + l * 1024, WO_WIN, 1024, 2304, 1024);
            add(p.in[I_GLUW] + (size_t)l * 512 * 512, nullptr, WO_GLU, 512, 512, 512);
            add(p.in[I_WOUT] + (size_t)l * 1024 * 1024, nullptr, WO_WOUT, 1024, 1024, 1024);
            add(p.in[I_WQ] + (size_t)l * 1024 * 1024, p.in[I_NXA] + l * 1024, WO_WQ, 1024, 1024, 1024);
            add(p.in[I_WK] + (size_t)l * 1024 * 1024, p.in[I_NMEM] + l * 1024, WO_WK, 1024, 1024, 1024);
            add(p.in[I_WV] + (size_t)l * 1024 * 1024, p.in[I_NMEM] + l * 1024, WO_WV, 1024, 1024, 1024);
            add(p.in[I_WO] + (size_t)l * 1024 * 1024, nullptr, WO_WO, 1024, 1024, 1024);
            add(p.in[I_PWQ] + (size_t)l * 1024 * 2048, p.in[I_NFFN] + l * 1024, WO_WPQ, 1024, 2048, 1024);
            add(p.in[I_W2] + (size_t)l * 64 * 512, nullptr, WO_W2T, 64, 512, 64);
            add(p.in[I_A2] + (size_t)l * 64 * 512, nullptr, WO_A2T, 64, 512, 64);
            add(p.in[I_G2] + (size_t)l * 128 * 512, nullptr, WO_G2T, 128, 512, 128);
            if (l == 1) {
                add(p.in[I_V1], p.in[I_NORM_MIX] + 1024, WO_WIN + (size_t)2304 * 1024 * 2, 1024, 32, 1024);
                add(p.in[I_V2], nullptr, WO_V2T, 32, 512, 32);
            }
        }
        int acc = 0;
        for (int i = 0; i < n; ++i) { pre[i] = acc; acc += ((tab[i].K + 63) >> 6) * ((tab[i].N + 63) >> 6); }
        pre[n] = acc; pre[NMAT + 1] = n;
    }
    __syncthreads();
    const int nmat = pre[NMAT + 1];
    const int total = pre[nmat];
    LAS float* tile = (LAS float*)lds;
    auto locate = [&](int u, int& mi, TMat& m, int& k0, int& n0) {
        while (mi + 1 < nmat && pre[mi + 1] <= u) ++mi;
        m = tab[mi];
        const int loc = u - pre[mi];
        const int ntn = (m.N + 63) >> 6;
        k0 = (loc / ntn) * 64; n0 = (loc % ntn) * 64;
    };
    int mi_f = 0, mi_w = 0;
    auto fetch = [&](int u, float (&v)[8]) {
        TMat m; int k0, n0; locate(u, mi_f, m, k0, n0);
#pragma unroll
        for (int ps = 0; ps < 8; ++ps) {
            const int r = ps * 8 + (tid >> 6), c = tid & 63, k = k0 + r, n = n0 + c;
            float x = 0.f;
            if (k < m.K && n < m.N) { x = m.src[(size_t)k * m.ld_src + n]; if (m.gain) x *= m.gain[k]; }
            v[ps] = x;
        }
    };
    float va[8];
    if (bid < total) fetch(bid, va);
#pragma unroll 1
    for (int u = bid; u < total; u += G) {
#pragma unroll
        for (int ps = 0; ps < 8; ++ps) tile[(ps * 8 + (tid >> 6)) * 65 + (tid & 63)] = va[ps];
        __syncthreads();
        if (u + G < total) fetch(u + G, va);
        TMat m; int k0, n0; locate(u, mi_w, m, k0, n0);
#pragma unroll
        for (int ps = 0; ps < 8; ++ps) {
            const int nn = ps * 8 + (tid >> 6), kk = tid & 63;
            if (n0 + nn < m.N && k0 + kk < m.K) m.dst[(size_t)(n0 + nn) * m.ld_dst + k0 + kk] = f2bf(tile[kk * 65 + nn]);
        }
        __syncthreads();
    }
}

__device__ void convert_tables(const Params& p, int l, int part, int nparts) {
    const float* u = p.in[I_PU] + (size_t)l * 16384 * 1024;
    const float* v = p.in[I_PV] + (size_t)l * 16384 * 1024;
    const float* g = p.in[I_NFFN] + l * 1024;
    unsigned* ub = (unsigned*)(p.ws + WS_UB + (size_t)l * 16384 * 1024);
    unsigned* vb = (unsigned*)(p.ws + WS_VB + (size_t)l * 16384 * 1024);
    float* su = (float*)(wt_layer(p, l) + WO_SU);
    float* sv = (float*)(wt_layer(p, l) + WO_SV);
    const int tidc = tid_opaque(), lane = tidc & 63, wave = tidc >> 6;
    float4 gg[4];
#pragma unroll
    for (int j = 0; j < 4; ++j) gg[j] = ((const float4*)g)[lane + 64 * j];
#pragma unroll 1
    for (int row = part * 8 + wave; row < 16384; row += nparts * 8) {
        float4 a[4], b[4]; float am = 0.f, bm = 0.f;
#pragma unroll
        for (int j = 0; j < 4; ++j) {
            a[j] = ((const float4*)(u + (size_t)row * 1024))[lane + 64 * j];
            b[j] = ((const float4*)(v + (size_t)row * 1024))[lane + 64 * j];
            a[j].x *= gg[j].x; a[j].y *= gg[j].y; a[j].z *= gg[j].z; a[j].w *= gg[j].w;
            am = fmaxf(am, fmaxf(fmaxf(fabsf(a[j].x), fabsf(a[j].y)), fmaxf(fabsf(a[j].z), fabsf(a[j].w))));
            bm = fmaxf(bm, fmaxf(fmaxf(fabsf(b[j].x), fabsf(b[j].y)), fmaxf(fabsf(b[j].z), fabsf(b[j].w))));
        }
        am = wave_max(am); bm = wave_max(bm);
        const float ia = am > 0.f ? 127.0f / am : 0.f, ib = bm > 0.f ? 127.0f / bm : 0.f;
#pragma unroll
        for (int j = 0; j < 4; ++j) {
            const int q0 = (int)rintf(a[j].x * ia), q1 = (int)rintf(a[j].y * ia), q2 = (int)rintf(a[j].z * ia), q3 = (int)rintf(a[j].w * ia);
            ub[(size_t)row * 256 + lane + 64 * j] = (unsigned)(q0 & 255) | ((unsigned)(q1 & 255) << 8) | ((unsigned)(q2 & 255) << 16) | ((unsigned)(q3 & 255) << 24);
            const int r0 = (int)rintf(b[j].x * ib) & 255, r1 = (int)rintf(b[j].y * ib) & 255, r2 = (int)rintf(b[j].z * ib) & 255, r3 = (int)rintf(b[j].w * ib) & 255;
            { const int d = lane + 64 * j;
              vb[(size_t)(d >> 5) * (16384 * 32) + (size_t)row * 32 + (d & 31)] = (unsigned)r0 | ((unsigned)r1 << 8) | ((unsigned)r2 << 16) | ((unsigned)r3 << 24); }
        }
        if (lane == 0) { su[row] = am * (1.0f / 127.0f); sv[row] = bm * (1.0f / 127.0f); }
    }
}

__device__ void p0_prep(const Params& p, ldsp lds) {
    const int tid = tid_opaque(), lane = tid & 63, wave = tid >> 6, G = gridDim.x, bid = bid_opaque();
    {
        const float* x = p.in[I_X]; float* xo = p.out; unsigned* xq = (unsigned*)(p.ws + WS_XQ); float* rs = (float*)(p.ws + WS_RS); float* sx = (float*)(p.ws + WS_SX);
#pragma unroll 1
        for (int row = bid * 8 + wave; row < T_TOK; row += G * 16) {
            const int row2 = row + G * 8;
            const bool has2 = row2 < T_TOK;
            float4 v[2][4];
#pragma unroll
            for (int j = 0; j < 4; ++j) v[0][j] = ((const float4*)(x + (size_t)row * DM))[lane + 64 * j];
#pragma unroll
            for (int j = 0; j < 4; ++j) v[1][j] = has2 ? ((const float4*)(x + (size_t)row2 * DM))[lane + 64 * j] : make_float4(0.f, 0.f, 0.f, 0.f);
#pragma unroll
            for (int q = 0; q < 2; ++q) {
                const int rw = q ? row2 : row;
                if (q && !has2) break;
                float ss = 0.f, am = 0.f;
#pragma unroll
                for (int j = 0; j < 4; ++j) {
                    ss += v[q][j].x * v[q][j].x + v[q][j].y * v[q][j].y + v[q][j].z * v[q][j].z + v[q][j].w * v[q][j].w;
                    am = fmaxf(am, fmaxf(fmaxf(fabsf(v[q][j].x), fabsf(v[q][j].y)), fmaxf(fabsf(v[q][j].z), fabsf(v[q][j].w))));
                }
                ss = wave_sum(ss); am = wave_max(am);
                const float ia = am > 0.f ? 127.0f / am : 0.f;
#pragma unroll
                for (int j = 0; j < 4; ++j) {
                    ((float4*)(xo + (size_t)rw * DM))[lane + 64 * j] = v[q][j];
                    const int q0 = (int)rintf(v[q][j].x * ia), q1 = (int)rintf(v[q][j].y * ia), q2 = (int)rintf(v[q][j].z * ia), q3 = (int)rintf(v[q][j].w * ia);
                    xq[(size_t)rw * 256 + lane + 64 * j] = (unsigned)(q0 & 255) | ((unsigned)(q1 & 255) << 8) | ((unsigned)(q2 & 255) << 16) | ((unsigned)(q3 & 255) << 24);
                }
                if (lane == 0) { rs[rw] = __builtin_amdgcn_rsqf(ss * (1.0f / DM) + RMS_EPS); sx[rw] = am * (1.0f / 127.0f); }
            }
        }
    }
    {
        const float* m = p.in[I_MEM]; bf16_t* mb = (bf16_t*)(p.ws + WS_MEMB);
        for (int row = bid * 8 + wave; row < NB * 256; row += G * 8) {
            float ss = 0.f; float4 v[4];
#pragma unroll
            for (int j = 0; j < 4; ++j) { v[j] = ((const float4*)(m + (size_t)row * DM))[lane + 64 * j]; ss += v[j].x * v[j].x + v[j].y * v[j].y + v[j].z * v[j].z + v[j].w * v[j].w; }
            ss = wave_sum(ss);
            const float r = __builtin_amdgcn_rsqf(ss * (1.0f / DM) + RMS_EPS);
#pragma unroll
            for (int j = 0; j < 4; ++j) { uint2 o; o.x = pack2(v[j].x * r, v[j].y * r); o.y = pack2(v[j].z * r, v[j].w * r); ((uint2*)(mb + (size_t)row * DM))[lane + 64 * j] = o; }
        }
    }
    p0_transposes(p, lds);
    {
        uint4* d = (uint4*)(wt_layer(p, 1) + WO_WIN + (size_t)2336 * 1024 * 2);
        const size_t n = (size_t)(2560 - 2336) * 1024 * 2 / 16;
        for (size_t i = (size_t)bid * NTHREADS + tid; i < n; i += (size_t)G * NTHREADS) d[i] = make_uint4(0, 0, 0, 0);
    }
    for (int l = 0; l < NL; ++l) {
        const float* k = p.in[I_PKEYS] + (size_t)l * 16 * 128 * 128; bf16_t* kb = (bf16_t*)(wt_layer(p, l) + WO_KEYS);
        for (int i = bid * NTHREADS + tid; i < 16 * 128 * 128; i += G * NTHREADS) kb[i] = f2bf(k[i]);
    }
    for (int j = bid * NTHREADS + tid; j < NL * 32 * 64 * 16; j += G * NTHREADS) {
        const int i = j >> 4, c = j & 15;
        const int l = i / 2048, gp = i % 2048, g = gp >> 6, pp = gp & 63;
        unsigned char* W = wt_layer(p, l);
        const float are = p.in[I_S5ARE][l * 2048 + gp], aim = p.in[I_S5AIM][l * 2048 + gp];
        const float lre = fminf(are, -1e-4f), lim = aim;
        const float dt = expf(p.in[I_S5DT][l * 32 + g]);
        const float mag = expf(lre * dt);
        const float lbre = mag * cosf(lim * dt), lbim = mag * sinf(lim * dt);
        const float den = lre * lre + lim * lim;
        const float c1re = ((lbre - 1.0f) * lre + lbim * lim) / den;
        const float c1im = (lbim * lre - (lbre - 1.0f) * lim) / den;
        float* bb = (float*)(W + WO_BBAR) + (size_t)gp * 32;
        const float bre = p.in[I_S5BRE][((size_t)l * 2048 + gp) * 16 + c];
        const float bim = p.in[I_S5BIM][((size_t)l * 2048 + gp) * 16 + c];
        bf16_t* bb2 = (bf16_t*)(W + WO_BB2) + ((size_t)g * 128 + 2 * pp) * 16;
        const float b0 = c1re * bre - c1im * bim, b1 = c1re * bim + c1im * bre;
        bb[c] = b0; bb[16 + c] = b1; bb2[c] = f2bf(b0); bb2[16 + c] = f2bf(b1);
        if (c == 0) {
            float pr = lbre, pi = lbim;
            for (int s_ = 0; s_ < 6; ++s_) { const float nr = pr * pr - pi * pi, ni = 2.f * pr * pi; pr = nr; pi = ni; }
            float* lam = (float*)(W + WO_LAM) + (size_t)gp * 4;
            lam[0] = lbre; lam[1] = lbim; lam[2] = pr; lam[3] = pi;
        }
        bf16_t* cm = (bf16_t*)(W + WO_CMAT) + (size_t)g * 16 * 128;
        const float* cre = p.in[I_S5CRE] + ((size_t)l * 32 + g) * 16 * 64;
        const float* cim = p.in[I_S5CIM] + ((size_t)l * 32 + g) * 16 * 64;
        cm[c * 128 + 2 * pp] = f2bf(cre[c * 64 + pp]); cm[c * 128 + 2 * pp + 1] = f2bf(-cim[c * 64 + pp]);
    }
}

__device__ __forceinline__ u32x4 q16(const float* f, float ia) {
    u32x4 w;
#pragma unroll
    for (int j = 0; j < 4; ++j) {
        const int q0 = (int)rintf(f[4 * j] * ia), q1 = (int)rintf(f[4 * j + 1] * ia), q2 = (int)rintf(f[4 * j + 2] * ia), q3 = (int)rintf(f[4 * j + 3] * ia);
        w[j] = (unsigned)(q0 & 255) | ((unsigned)(q1 & 255) << 8) | ((unsigned)(q2 & 255) << 16) | ((unsigned)(q3 & 255) << 24);
    }
    return w;
}
__device__ void p0b_quant_weights(const Params& p) {
    const int tid = tid_opaque(), lane = tid & 63, wave = tid >> 6, G = gridDim.x, bid = bid_opaque();
#pragma unroll 1
    for (int r0 = bid * 8 + wave; r0 < NL * SW_TOTAL; r0 += G * 32) {
        u32x4 av[4], bv[4]; size_t o8[4]; int ii[4], ll[4]; bool ok[4];
#pragma unroll
        for (int u = 0; u < 4; ++u) {
            const int r = r0 + u * G * 8;
            const int l = r / SW_TOTAL, i = r % SW_TOTAL;
            ok[u] = r < NL * SW_TOTAL && !(i >= SW_WOUT && i < SW_WQ);
            size_t off = WO_WIN, off8 = W8_WIN; int rr = i;
            if (i < SW_WOUT) { off = WO_WIN; off8 = W8_WIN; rr = i; } else if (i < SW_WO) { off = WO_WQ; off8 = W8_WQ; rr = i - SW_WQ; }
            else if (i < SW_WPQ) { off = WO_WO; off8 = W8_WO; rr = i - SW_WO; } else { off = WO_WPQ; off8 = W8_WPQ; rr = i - SW_WPQ; }
            ii[u] = i; ll[u] = l;
            o8[u] = (size_t)l * W8_LAYER + off8 + ((size_t)((rr >> 9) * 16 + (lane >> 2))) * 32768 + (rr & 511) * 64 + (lane & 3) * 16;
            av[u] = (u32x4){0u, 0u, 0u, 0u}; bv[u] = av[u];
            if (ok[u]) { const unsigned char* row = wt_layer(p, l) + off + (size_t)rr * 2048; av[u] = *(const u32x4*)(row + lane * 32); bv[u] = *(const u32x4*)(row + lane * 32 + 16); }
        }
#pragma unroll
        for (int u = 0; u < 4; ++u) {
            if (!ok[u]) continue;
            float f[16]; unpack8(av[u], f); unpack8(bv[u], f + 8);
            float am = 0.f;
#pragma unroll
            for (int j = 0; j < 16; ++j) am = fmaxf(am, fabsf(f[j]));
            am = wave_max(am);
            const u32x4 w = q16(f, am > 0.f ? 127.0f / am : 0.f);
            *(u32x4*)(p.ws + WS_W8 + o8[u]) = w;
            if (lane == 0) ((float*)(wt_layer(p, ll[u]) + WO_SW))[ii[u]] = am * (1.0f / 127.0f);
        }
    }
}

#define TILE_ROWS(rr) for (int rr = wave; rr < 128; rr += 8)
#define TILE_ROWS4(r0) for (int r0 = wave; r0 < 128; r0 += 32)
__device__ __forceinline__ f32x4 tile4(ldsp lds, int rr, int lane) { return *(LAS f32x4*)(lds + ((size_t)rr * 260 + lane * 4) * 4); }
__device__ __forceinline__ f32x4 tile4i(ldsp lds, int rr, int lane) { const i32x4 v = *(LAS i32x4*)(lds + ((size_t)rr * 260 + lane * 4) * 4); return (f32x4){(float)v[0], (float)v[1], (float)v[2], (float)v[3]}; }
__device__ __forceinline__ void st_bf4(bf16_t* d, float a, float b, float c, float e) { uint2 o; o.x = pack2(a, b); o.y = pack2(c, e); *(uint2*)d = o; }

template <class RS>
__device__ __forceinline__ void z_rowpass(ldsp lds, bf16_t* z, RS rowscale, const float* sw, int row0, int col0, int nvalid, int lane, int wave) {
    const float4 w4 = *(const float4*)(sw + col0 + lane * 4);
    const int col = col0 + lane * 4;
    TILE_ROWS4(r0) {
        f32x4 v[4]; float r[4];
#pragma unroll
        for (int u = 0; u < 4; ++u) { v[u] = tile4i(lds, r0 + 8 * u, lane); r[u] = rowscale(r0 + 8 * u); }
        __builtin_amdgcn_sched_group_barrier(0x100, 12, 0);
#pragma unroll
        for (int u = 0; u < 4; ++u)
            if (col < nvalid) st_bf4(z + (size_t)(row0 + r0 + 8 * u) * ZC + col, v[u][0] * r[u] * w4.x, v[u][1] * r[u] * w4.y, v[u][2] * r[u] * w4.z, v[u][3] * r[u] * w4.w);
    }
}

__device__ void phase_a(const Params& p, int l, bool with_kv, ldsp lds) {
    const int G = gridDim.x, bid = bid_opaque();
    const int nz = 256 * 5;
    const int total = nz + (with_kv ? NL * 64 : 0);
    const unsigned char* xq = p.ws + WS_XQ;
#pragma unroll 1
    for (int u = bid; u < total; u += G) {
        int tid = threadIdx.x;
        asm volatile("" : "+v"(tid));
        const int lane = tid & 63, wave = __builtin_amdgcn_readfirstlane(tid >> 6);
        if (u < nz) {
            const int rt = u & 255, ct = u >> 8;
            const int nvalid = (l == 0) ? ZN0 : ZN1;
            const float* rsg = (const float*)(p.ws + WS_RS) + rt * 128; const float* sxg = (const float*)(p.ws + WS_SX) + rt * 128;
            const float* sw = (const float*)(wt_layer(p, l) + WO_SW) + SW_WIN;
            i32x16 acc5[2][4];
            gemm512_acc<true>(xq + (size_t)rt * 128 * 1024, 1024, p.ws + WS_W8 + (size_t)l * W8_LAYER + W8_WIN + (size_t)ct * 524288, 64, 32768, 1024, lds, acc5);
#pragma unroll 1
            for (int h = 0; h < 2; ++h) {
                gemm512_store_half(acc5, h, lds);
                z_rowpass(lds, (bf16_t*)(p.ws + WS_Z), [&](int rr) { return rsg[rr] * sxg[rr]; }, sw, rt * 128, ct * 512 + h * 256, nvalid, lane, wave);
                __syncthreads();
            }
        } else {
            const int v = u - nz, ll = v >> 6, w = v & 63, isv = w >> 5, t5 = w & 31, rt = t5 >> 2, ct = t5 & 3;
            const bf16_t* memb = (const bf16_t*)(p.ws + WS_MEMB);
            bf16_t* dst; int bb, hh, r0;
            if (!isv) {
                bb = rt >> 1; hh = ct; r0 = (rt & 1) * 128;
                dst = (bf16_t*)(p.ws + WS_KMEM) + (size_t)ll * 1024 * 1024;
                gemm_to_lds<256>(memb + (size_t)rt * 128 * DM, DM, (const bf16_t*)(wt_layer(p, ll) + WO_WK) + (size_t)ct * 256 * DM, DM, DM, lds);
            } else {
                bb = ct; hh = rt >> 1; r0 = (rt & 1) * 128;
                dst = (bf16_t*)(p.ws + WS_VMEMT) + (size_t)ll * 1024 * 1024;
                gemm_to_lds<256>((const bf16_t*)(wt_layer(p, ll) + WO_WV) + (size_t)rt * 128 * DM, DM, memb + (size_t)ct * 256 * DM, DM, DM, lds);
            }
            TILE_ROWS(rr) { const f32x4 v4 = tile4(lds, rr, lane); st_bf4(dst + ((size_t)(((bb * 4 + hh) * 4 + (lane >> 4)) * 256 + r0 + rr)) * 64 + (lane & 15) * 4, v4[0], v4[1], v4[2], v4[3]); }
        }
        __syncthreads();
    }
}

constexpr size_t WS_F1 = WS_SCR;
constexpr size_t WS_ZS = WS_F1 + (size_t)32 * NCH * 4096 * 2;
constexpr size_t WS_SE = WS_ZS + (size_t)32 * NCH * 4096 * 2;
constexpr size_t WS_BETA = WS_SE + (size_t)128 * NCH * 128 * 4;
static_assert(WS_BETA + (size_t)4096 * 64 * 4 <= WS_END, "scratch overflow");
__device__ __forceinline__ bf16_t* q1_ptr(unsigned char* ws, int l, int item) {
    return (bf16_t*)(ws + ((item >= 2048) ? WS_VB : WS_UB) + (size_t)(1 - l) * 16384 * 1024 + (size_t)(item & 2047) * 8192);
}

constexpr int FS = 68;
constexpr int FB = 64 * FS * 4;
constexpr int HB = 64 * 72 * 2;
constexpr int HS = 144;
constexpr int L_R = 0, L_K = FB, L_LD = 2 * FB, L_AS = 3 * FB, L_V = 4 * FB;
constexpr int L_H = 5 * FB;
#define HSLOT(i) (L_H + (i) * HB)
#define GSLOT(i) ((i) * HB)
constexpr int L_BETA = L_H + 7 * HB, L_PC = L_BETA + 256, L_PART = L_PC + 256;
constexpr int L_CST = L_PART + 2048;
constexpr int L_YF = GSLOT(2);
constexpr int L_GF = HSLOT(3);

template <int KS>
__device__ __forceinline__ f32x16 mm32(ldsp A, int lda, ldsp B, int ldb, int mi, int ni, int lane, f32x16 acc) {
    const int fr = lane & 31, fh = lane >> 5;
#pragma unroll
    for (int k0 = 0; k0 < KS; k0 += 4) {
        constexpr int NK = KS < 4 ? KS : 4;
        bf16x8 a[NK], b[NK];
#pragma unroll
        for (int kk = 0; kk < NK; ++kk) {
            a[kk] = *(LAS bf16x8*)(A + (mi * 32 + fr) * lda + ((k0 + kk) * 16 + fh * 8) * 2);
            b[kk] = *(LAS bf16x8*)(B + (ni * 32 + fr) * ldb + ((k0 + kk) * 16 + fh * 8) * 2);
        }
        __builtin_amdgcn_sched_group_barrier(0x100, 2 * NK, 0);
#pragma unroll
        for (int kk = 0; kk < NK; ++kk) acc = __builtin_amdgcn_mfma_f32_32x32x16_bf16(a[kk], b[kk], acc, 0, 0, 0);
        __builtin_amdgcn_sched_group_barrier(0x008, NK, 0);
    }
    return acc;
}
__device__ __forceinline__ f32x16 zero16() { f32x16 a; for (int r = 0; r < 16; ++r) a[r] = 0.f; return a; }
#define ACCROW(mi, r, fh) ((mi) * 32 + ((r) & 3) + 8 * ((r) >> 2) + 4 * (fh))
__device__ __forceinline__ void hst4(ldsp buf, int stride, int row, int col, float a, float b, float c, float d) { using u2 = __attribute__((ext_vector_type(2))) unsigned; u2 o; o[0] = pack2(a, b); o[1] = pack2(c, d); *(LAS u2*)(buf + row * stride + col * 2) = o; }
__device__ __forceinline__ f32x4 hld4(ldsp buf, int stride, int row, int col) { using u2 = __attribute__((ext_vector_type(2))) unsigned; const u2 w = *(LAS u2*)(buf + row * stride + col * 2); return (f32x4){bflo(w[0]), bfhi(w[0]), bflo(w[1]), bfhi(w[1])}; }
#define ACCBASE(mi, g, fh) ((mi) * 32 + 8 * (g) + 4 * (fh))
__device__ __forceinline__ void hst(ldsp buf, int row, int col, float v) { *(LAS bf16_t*)(buf + row * HS + col * 2) = f2bf(v); }
__device__ __forceinline__ float hld(ldsp buf, int row, int col) { return bf2f(*(LAS bf16_t*)(buf + row * HS + col * 2)); }

struct ZPre { u32x4 cw[5], pw[5]; u32x4 hv; uint2 vf[4]; };
struct HeadW { u32x4 w2, a2, v2, g2[4]; };
constexpr int C_W0 = 0, C_A0 = 64, C_KK = 128, C_KA = 192, C_RK = 256, C_V0 = 320, C_LNG = 384, C_LNB = 448, C_MU = 512, C_MUG = 832;
__device__ __forceinline__ void zpre_load(const unsigned char* ws, int item, int tid, ZPre& zp_, int l) {
    const int bh = item & 31, c = item >> 5, b = bh >> 3, h = bh & 7, pt = tid >> 3, pq = tid & 7;
    const bf16_t* zc = (const bf16_t*)(ws + WS_Z) + ((size_t)b * SEQ + (size_t)c * 64 + pt) * ZC + pq * 8;
    const bool hasprev = !(c == 0 && pt == 0);
    const int cols[5] = {h * 64, 512 + h * 64, 1024 + h * 64, 1536, 1600};
#pragma unroll
    for (int i = 0; i < 5; ++i) {
        zp_.cw[i] = *(const u32x4*)(zc + cols[i]);
        zp_.pw[i] = (u32x4){0u, 0u, 0u, 0u};
        if (hasprev) zp_.pw[i] = *(const u32x4*)(zc - ZC + cols[i]);
    }
    zp_.hv = (u32x4){0u, 0u, 0u, 0u};
#pragma unroll
    for (int g = 0; g < 4; ++g) zp_.vf[g] = make_uint2(0u, 0u);
    if (l == 1) {
        if (pq < 4) zp_.hv = *(const u32x4*)(zc + 2304);
        const int wave = tid >> 6, lane = tid & 63;
        if (wave < 4) {
            const int mi = wave >> 1, ni = wave & 1, fr = lane & 31, fh = lane >> 5, t = ni * 32 + fr;
            const bf16_t* vfirst = (const bf16_t*)(ws + WS_VFIRST);
#pragma unroll
            for (int g = 0; g < 4; ++g) zp_.vf[g] = *(const uint2*)(vfirst + ((size_t)b * SEQ + (size_t)c * 64 + t) * 512 + h * 64 + (mi * 32 + 8 * g + 4 * fh));
        }
    }
}
__device__ __forceinline__ void head_consts_load(const Params& p, int l, int h, int tid, ldsp lds, HeadW& hw, int mode) {
    unsigned char* W = p.ws + WS_WT + (size_t)l * WT_LAYER;
    const int pt = tid >> 3, pq = tid & 7;
    hw.w2 = *(const u32x4*)((const bf16_t*)(W + WO_W2T) + h * 4096 + pt * 64 + pq * 8);
    hw.a2 = *(const u32x4*)((const bf16_t*)(W + WO_A2T) + h * 4096 + pt * 64 + pq * 8);
    hw.v2 = (u32x4){0u, 0u, 0u, 0u};
    if (pq < 4) hw.v2 = *(const u32x4*)((const bf16_t*)(W + WO_V2T) + h * 2048 + pt * 32 + pq * 8);
#pragma unroll
    for (int i = 0; i < 4; ++i) { hw.g2[i] = (u32x4){0u, 0u, 0u, 0u}; if (mode == 1 && i < 2) hw.g2[i] = *(const u32x4*)((const bf16_t*)(W + WO_G2T) + h * 8192 + (tid + 512 * i) * 8); }
    const float* mu = p.in[I_MU] + l * 1792;
    LAS float* CST = (LAS float*)(lds + L_CST);
    for (int e = tid; e < 960; e += NTHREADS) {
        const int sg = e >> 6, j = e & 63;
        const float* src;
        if (sg == 0) src = p.in[I_W0] + l * 512 + h * 64;
        else if (sg == 1) src = p.in[I_A0] + l * 512 + h * 64;
        else if (sg == 2) src = p.in[I_KK] + l * 512 + h * 64;
        else if (sg == 3) src = p.in[I_KA] + l * 512 + h * 64;
        else if (sg == 4) src = p.in[I_RK] + l * 512 + h * 64;
        else if (sg == 5) src = p.in[I_V0] + h * 64;
        else if (sg == 6) src = p.in[I_LNG] + l * 512 + h * 64;
        else if (sg == 7) src = p.in[I_LNB] + l * 512 + h * 64;
        else if (sg <= 10) src = mu + (sg - 8) * 512 + h * 64;
        else if (sg == 11) src = mu + 1536;
        else if (sg == 12) src = mu + 1600;
        else src = mu + 1664 + (sg - 13) * 64;
        CST[e] = src[j];
    }
    __syncthreads();
}
__device__ void rwkv_chunk(const Params& p, int l, int item, int mode, ldsp lds, const ZPre& zcur, ZPre& znext, int item_next, const HeadW& hw) {
    int tid = threadIdx.x;
    asm volatile("" : "+v"(tid));
    const int lane = tid & 63, wave = __builtin_amdgcn_readfirstlane(tid >> 6);
    unsigned char* wsl = ptr_opaque(p.ws);
    const int bh = item & 31, c = item >> 5;
    const int b = bh >> 3, h = bh & 7;
    const bf16_t* z = (const bf16_t*)(wsl + WS_Z);
    bf16_t* ymix = (bf16_t*)(wsl + WS_YMIX);
    bf16_t* vfirst = (bf16_t*)(wsl + WS_VFIRST);
    LAS float* CST = (LAS float*)(lds + L_CST);
    LAS float* R = (LAS float*)(lds + L_R); LAS float* KA = (LAS float*)(lds + L_K); LAS float* LD = (LAS float*)(lds + L_LD);
    LAS float* AS = (LAS float*)(lds + L_AS); LAS float* V = (LAS float*)(lds + L_V);
    LAS float* BETA = (LAS float*)(lds + L_BETA); LAS float* PC = (LAS float*)(lds + L_PC); LAS float* PART = (LAS float*)(lds + L_PART);
    const size_t g0 = (size_t)b * SEQ + (size_t)c * 64;
    const int pt = tid >> 3, pq = tid & 7;
    const bool hasprev = !(c == 0 && pt == 0);
    const bf16_t* zc = z + (g0 + pt) * ZC;
    const bf16_t* zp = zc - ZC;
    if (item_next >= 0) zpre_load(wsl, item_next, tid, znext, l);
    auto seg = [&](int si, int col0, float* o) {
        float cf[8], pf[8]; unpack8(zcur.cw[si], cf); unpack8(zcur.pw[si], pf);
        const f32x4 m0 = *(LAS f32x4*)(CST + C_MU + si * 64 + pq * 8), m1 = *(LAS f32x4*)(CST + C_MU + si * 64 + pq * 8 + 4);
        const float mm[8] = {m0[0], m0[1], m0[2], m0[3], m1[0], m1[1], m1[2], m1[3]};
#pragma unroll
        for (int i = 0; i < 8; ++i) o[i] = cf[i] + (pf[i] - cf[i]) * mm[i];
    };
    u32x4 s0pref = {0u, 0u, 0u, 0u};
    if (mode == 1) s0pref = *(const u32x4*)((const bf16_t*)(wsl + WS_ZS) + (size_t)(bh * NCH + c) * 4096 + tid * 8);
    {
        float f[8];
        seg(0, h * 64, f);
        *(LAS f32x4*)(R + pt * FS + pq * 8) = (f32x4){f[0], f[1], f[2], f[3]}; *(LAS f32x4*)(R + pt * FS + pq * 8 + 4) = (f32x4){f[4], f[5], f[6], f[7]};
        seg(1, 512 + h * 64, f);
        *(LAS f32x4*)(KA + pt * FS + pq * 8) = (f32x4){f[0], f[1], f[2], f[3]}; *(LAS f32x4*)(KA + pt * FS + pq * 8 + 4) = (f32x4){f[4], f[5], f[6], f[7]};
        seg(2, 1024 + h * 64, f);
        *(LAS f32x4*)(V + pt * FS + pq * 8) = (f32x4){f[0], f[1], f[2], f[3]}; *(LAS f32x4*)(V + pt * FS + pq * 8 + 4) = (f32x4){f[4], f[5], f[6], f[7]};
        if (l == 0 && mode == 0) {
            u32x4 o; o[0] = pack2(f[0], f[1]); o[1] = pack2(f[2], f[3]); o[2] = pack2(f[4], f[5]); o[3] = pack2(f[6], f[7]);
            *(u32x4*)(vfirst + (g0 + pt) * 512 + h * 64 + pq * 8) = o;
        }
        seg(3, 1536, f);
        { u32x4 o; o[0] = pack2(tanh_(f[0]), tanh_(f[1])); o[1] = pack2(tanh_(f[2]), tanh_(f[3])); o[2] = pack2(tanh_(f[4]), tanh_(f[5])); o[3] = pack2(tanh_(f[6]), tanh_(f[7]));
          *(LAS u32x4*)(lds + HSLOT(0) + pt * HS + pq * 16) = o; }
        *(LAS u32x4*)(lds + HSLOT(2) + pt * HS + pq * 16) = hw.w2;
        seg(4, 1600, f);
        { u32x4 o; o[0] = pack2(f[0], f[1]); o[1] = pack2(f[2], f[3]); o[2] = pack2(f[4], f[5]); o[3] = pack2(f[6], f[7]);
          *(LAS u32x4*)(lds + HSLOT(1) + pt * HS + pq * 16) = o; }
        *(LAS u32x4*)(lds + HSLOT(3) + pt * HS + pq * 16) = hw.a2;
        if (l == 1 && pq < 4) {
            *(LAS u32x4*)(lds + HSLOT(4) + pt * 80 + pq * 16) = zcur.hv;
            *(LAS u32x4*)(lds + HSLOT(5) + pt * 80 + pq * 16) = hw.v2;
        }
    }
    __syncthreads();
    {
        const int w4 = wave & 3, mi = w4 >> 1, ni = w4 & 1, fr = lane & 31, fh = lane >> 5;
        const int t = ni * 32 + fr;
        if (wave < 4) {
            const f32x16 acc = mm32<4>(lds + HSLOT(2), HS, lds + HSLOT(0), HS, mi, ni, lane, zero16());
#pragma unroll
            for (int g = 0; g < 4; ++g) {
                const int n = ACCBASE(mi, g, fh);
                const f32x4 wq = *(LAS f32x4*)(CST + C_W0 + n); const float4 wv = make_float4(wq[0], wq[1], wq[2], wq[3]);
                f32x4 o;
                { float w = wv.x + acc[4 * g];     w = -softplus_(-w) - 0.5f; o[0] = -__expf(w); }
                { float w = wv.y + acc[4 * g + 1]; w = -softplus_(-w) - 0.5f; o[1] = -__expf(w); }
                { float w = wv.z + acc[4 * g + 2]; w = -softplus_(-w) - 0.5f; o[2] = -__expf(w); }
                { float w = wv.w + acc[4 * g + 3]; w = -softplus_(-w) - 0.5f; o[3] = -__expf(w); }
                *(LAS f32x4*)(LD + t * FS + n) = o;
            }
        } else {
            const f32x16 acc = mm32<4>(lds + HSLOT(3), HS, lds + HSLOT(1), HS, mi, ni, lane, zero16());
#pragma unroll
            for (int g = 0; g < 4; ++g) {
                const int n = ACCBASE(mi, g, fh);
                const f32x4 aq = *(LAS f32x4*)(CST + C_A0 + n); const float4 av = make_float4(aq[0], aq[1], aq[2], aq[3]);
                *(LAS f32x4*)(AS + t * FS + n) = (f32x4){sigmoidf_(av.x + acc[4 * g]), sigmoidf_(av.y + acc[4 * g + 1]), sigmoidf_(av.z + acc[4 * g + 2]), sigmoidf_(av.w + acc[4 * g + 3])};
            }
        }
    }
    __syncthreads();
    if (l == 1) {
        if (wave < 4) {
            const int mi = wave >> 1, ni = wave & 1, fr = lane & 31, fh = lane >> 5;
            const int t = ni * 32 + fr;
            const f32x16 acc = mm32<2>(lds + HSLOT(5), 80, lds + HSLOT(4), 80, mi, ni, lane, zero16());
#pragma unroll
            for (int g = 0; g < 4; ++g) {
                const int n = ACCBASE(mi, g, fh);
                const f32x4 vq = *(LAS f32x4*)(CST + C_V0 + n); const float4 vv0 = make_float4(vq[0], vq[1], vq[2], vq[3]);
                const uint2 vfw = zcur.vf[g];
                f32x4 vv = *(LAS f32x4*)(V + t * FS + n);
                vv[0] += (bflo(vfw.x) - vv[0]) * sigmoidf_(vv0.x + acc[4 * g]);
                vv[1] += (bfhi(vfw.x) - vv[1]) * sigmoidf_(vv0.y + acc[4 * g + 1]);
                vv[2] += (bflo(vfw.y) - vv[2]) * sigmoidf_(vv0.z + acc[4 * g + 2]);
                vv[3] += (bfhi(vfw.y) - vv[3]) * sigmoidf_(vv0.w + acc[4 * g + 3]);
                *(LAS f32x4*)(V + t * FS + n) = vv;
                if (mode == 0) { uint2 o; o.x = pack2(vv[0], vv[1]); o.y = pack2(vv[2], vv[3]); *(uint2*)(vfirst + (g0 + t) * 512 + h * 64 + n) = o; }
            }
        }
    }
    {
        const int j = tid & 63, part = tid >> 6;
        float sacc = 0.f;
#pragma unroll
        for (int i = 0; i < 8; ++i) sacc += LD[(part * 8 + i) * FS + j];
        PART[part * 64 + j] = sacc;
        __syncthreads();
        float off = 0.f;
        for (int q = 0; q < part; ++q) off += PART[q * 64 + j];
#pragma unroll
        for (int i = 0; i < 8; ++i) { off += LD[(part * 8 + i) * FS + j]; LD[(part * 8 + i) * FS + j] = off; }
    }
    __syncthreads();
    {
        const int t = pt, q = pq;
        float kv[8], rr[8], av[8], lc[8], lx[8]; float ss = 0.f;
        {
            const f32x4 k0 = *(LAS f32x4*)(KA + t * FS + q * 8), k1 = *(LAS f32x4*)(KA + t * FS + q * 8 + 4);
            const f32x4 r0 = *(LAS f32x4*)(R + t * FS + q * 8), r1 = *(LAS f32x4*)(R + t * FS + q * 8 + 4);
            const f32x4 a0v = *(LAS f32x4*)(AS + t * FS + q * 8), a1v = *(LAS f32x4*)(AS + t * FS + q * 8 + 4);
            const f32x4 c0 = *(LAS f32x4*)(LD + t * FS + q * 8), c1 = *(LAS f32x4*)(LD + t * FS + q * 8 + 4);
            f32x4 x0 = {0.f, 0.f, 0.f, 0.f}, x1 = {0.f, 0.f, 0.f, 0.f};
            if (t > 0) { x0 = *(LAS f32x4*)(LD + (t - 1) * FS + q * 8); x1 = *(LAS f32x4*)(LD + (t - 1) * FS + q * 8 + 4); }
#pragma unroll
            for (int i = 0; i < 4; ++i) { kv[i] = k0[i]; kv[4 + i] = k1[i]; rr[i] = r0[i]; rr[4 + i] = r1[i]; av[i] = a0v[i]; av[4 + i] = a1v[i]; lc[i] = c0[i]; lc[4 + i] = c1[i]; lx[i] = x0[i]; lx[4 + i] = x1[i]; }
        }
        float kk[8];
#pragma unroll
        for (int i = 0; i < 8; ++i) { kk[i] = kv[i] * CST[C_KK + q * 8 + i]; ss += kk[i] * kk[i]; }
        ss = grp8_sum(ss);
        const float inv = fminf(__builtin_amdgcn_rsqf(ss), 1e12f);
        float bs = 0.f;
        float oa[8], orr[8], ob[8], ok[8];
#pragma unroll
        for (int i = 0; i < 8; ++i) {
            const int j = q * 8 + i;
            const float kkn = kk[i] * inv;
            const float kn = kv[i] * (1.0f + (av[i] - 1.0f) * CST[C_KA + j]);
            bs += rr[i] * kn * CST[C_RK + j];
            const float ep = __expf(lc[i]), em = rcp_(ep), ex = __expf(lx[i]);
            oa[i] = -kkn * ex; orr[i] = rr[i] * ep; ob[i] = kkn * av[i] * em; ok[i] = kn * em;
        }
        bs = grp8_sum(bs);
        if (q == 0) { BETA[t] = bs; if (mode == 0) ((float*)(wsl + WS_BETA))[(size_t)item * 64 + t] = bs; }
        if (t == 63) {
#pragma unroll
            for (int i = 0; i < 8; ++i) PC[q * 8 + i] = __expf(lc[i]);
        }
        u32x4 o;
        o[0] = pack2(oa[0], oa[1]); o[1] = pack2(oa[2], oa[3]); o[2] = pack2(oa[4], oa[5]); o[3] = pack2(oa[6], oa[7]);
        *(LAS u32x4*)(lds + HSLOT(0) + t * HS + q * 16) = o;
        o[0] = pack2(orr[0], orr[1]); o[1] = pack2(orr[2], orr[3]); o[2] = pack2(orr[4], orr[5]); o[3] = pack2(orr[6], orr[7]);
        *(LAS u32x4*)(lds + HSLOT(1) + t * HS + q * 16) = o;
        o[0] = pack2(ob[0], ob[1]); o[1] = pack2(ob[2], ob[3]); o[2] = pack2(ob[4], ob[5]); o[3] = pack2(ob[6], ob[7]);
        *(LAS u32x4*)(lds + HSLOT(2) + t * HS + q * 16) = o;
        o[0] = pack2(ok[0], ok[1]); o[1] = pack2(ok[2], ok[3]); o[2] = pack2(ok[4], ok[5]); o[3] = pack2(ok[6], ok[7]);
        *(LAS u32x4*)(lds + HSLOT(3) + t * HS + q * 16) = o;
        const f32x4 v0v = *(LAS f32x4*)(V + t * FS + q * 8), v1v = *(LAS f32x4*)(V + t * FS + q * 8 + 4);
#pragma unroll
        for (int i = 0; i < 8; ++i) {
            const int j = q * 8 + i;
            hst(lds + HSLOT(4), j, t, oa[i]);
            hst(lds + HSLOT(5), j, t, ob[i]);
            hst(lds + HSLOT(6), j, t, i < 4 ? v0v[i] : v1v[i - 4]);
        }
    }
    __syncthreads();
    auto n_tile = [&](int tt) {
        int ln_ = lane; asm volatile("" : "+v"(ln_));
        const int m = tt >> 2, mi = (tt >> 1) & 1, ni = tt & 1, fr = ln_ & 31, fh = ln_ >> 5;
        if (m == 1) {
            const f32x16 acc = mm32<4>(lds + HSLOT(0), HS, lds + HSLOT(3), HS, mi, ni, lane, zero16());
            const int sI = ni * 32 + fr;
#pragma unroll
            for (int g = 0; g < 4; ++g) {
                const int t = ACCBASE(mi, g, fh);
                hst4(lds + GSLOT(2), HS, sI, t, sI < t ? acc[4 * g] : 0.f, sI < t + 1 ? acc[4 * g + 1] : 0.f, sI < t + 2 ? acc[4 * g + 2] : 0.f, sI < t + 3 ? acc[4 * g + 3] : 0.f);
            }
        } else {
            const f32x16 acc = mm32<4>(lds + HSLOT(m == 3 ? 3 : 2), HS, lds + HSLOT(m == 0 ? 0 : 1), HS, mi, ni, lane, zero16());
            const int t = ni * 32 + fr;
#pragma unroll
            for (int g = 0; g < 4; ++g) {
                const int sI = ACCBASE(mi, g, fh);
                float v[4];
#pragma unroll
                for (int e = 0; e < 4; ++e) { const bool keep = (m == 0) ? (sI + e < t) : (sI + e <= t); v[e] = keep ? acc[4 * g + e] : 0.f; }
                if (m == 0) {
                    hst4(lds + GSLOT(0), HS, t, sI, v[0], v[1], v[2], v[3]);
                    hst4(lds + GSLOT(5), HS, t, sI, v[0] + (sI == t ? 1.f : 0.f), v[1] + (sI + 1 == t ? 1.f : 0.f), v[2] + (sI + 2 == t ? 1.f : 0.f), v[3] + (sI + 3 == t ? 1.f : 0.f));
#pragma unroll
                    for (int e = 0; e < 4; ++e) hst(lds + GSLOT(1), sI + e, t, v[e]);
                } else hst4(lds + GSLOT(m == 2 ? 3 : 4), HS, t, sI, v[0], v[1], v[2], v[3]);
            }
        }
    };
    n_tile(wave);
    __syncthreads();
    u32x4 gcw[4], gpw[4];
#pragma unroll
    for (int i = 0; i < 4; ++i) { gcw[i] = (u32x4){0u, 0u, 0u, 0u}; gpw[i] = (u32x4){0u, 0u, 0u, 0u}; }
    if (mode == 1 && wave >= 4) {
#pragma unroll
        for (int i = 0; i < 4; ++i) {
            const int e = tid - 256 + 256 * i, t = e >> 4, q8 = e & 15;
            const bf16_t* zcc = z + (g0 + t) * ZC + 1664 + q8 * 8;
            gcw[i] = *(const u32x4*)zcc;
            if (!(c == 0 && t == 0)) gpw[i] = *(const u32x4*)(zcc - ZC);
        }
    }
#pragma unroll 1
    for (int k = 0; k < 6; ++k) {
        const int Pc = (k & 1) ? GSLOT(6) : GSLOT(0), PcT = (k & 1) ? HSLOT(0) : GSLOT(1);
        const int Pn = (k & 1) ? GSLOT(0) : GSLOT(6), PnT = (k & 1) ? GSLOT(1) : HSLOT(0);
        const int Tp = (k & 1) ? GSLOT(5) : HSLOT(2), Tn = (k & 1) ? HSLOT(2) : GSLOT(5);
        const int w4 = wave & 3, mi = w4 >> 1, ni = w4 & 1, fr = lane & 31, fh = lane >> 5;
        if (wave < 4) {
            if (k < 5) {
                const f32x16 acc = mm32<4>(lds + Pc, HS, lds + PcT, HS, mi, ni, lane, zero16());
                const int j = ni * 32 + fr;
#pragma unroll
                for (int g = 0; g < 4; ++g) {
                    const int i = ACCBASE(mi, g, fh);
                    hst4(lds + PnT, HS, j, i, acc[4 * g], acc[4 * g + 1], acc[4 * g + 2], acc[4 * g + 3]);
#pragma unroll
                    for (int e = 0; e < 4; ++e) hst(lds + Pn, i + e, j, acc[4 * g + e]);
                }
            } else n_tile(12 + wave);
        } else {
            if (k >= 1) {
                const f32x16 acc = mm32<4>(lds + PcT, HS, lds + Tp, HS, mi, ni, lane, zero16());
                const int t = ni * 32 + fr;
#pragma unroll
                for (int g = 0; g < 4; ++g) {
                    const int sI = ACCBASE(mi, g, fh);
                    const f32x4 o = hld4(lds + Tp, HS, t, sI);
                    hst4(lds + Tn, HS, t, sI, acc[4 * g] + o[0], acc[4 * g + 1] + o[1], acc[4 * g + 2] + o[2], acc[4 * g + 3] + o[3]);
                }
            } else n_tile(8 + (wave - 4));
        }
        __syncthreads();
    }
    {
        const int w4 = wave & 3, mi = w4 >> 1, ni = w4 & 1, fr = lane & 31, fh = lane >> 5;
        const f32x16 acc = mm32<4>(lds + HSLOT(2), HS, lds + (wave < 4 ? HSLOT(4) : GSLOT(2)), HS, mi, ni, lane, zero16());
        const int n = ni * 32 + fr;
#pragma unroll
        for (int g = 0; g < 4; ++g) hst4(lds + (wave < 4 ? GSLOT(0) : GSLOT(1)), HS, n, ACCBASE(mi, g, fh), acc[4 * g], acc[4 * g + 1], acc[4 * g + 2], acc[4 * g + 3]);
    }
    __syncthreads();
    if (mode == 0) {
        {
            const int w4 = wave & 3, mi = w4 >> 1, ni = w4 & 1, fr = lane & 31, fh = lane >> 5;
            const f32x16 acc = mm32<4>(lds + (wave < 4 ? GSLOT(0) : GSLOT(1)), HS, lds + GSLOT(3), HS, mi, ni, lane, zero16());
            const int t = ni * 32 + fr;
            bf16_t* Q1g = q1_ptr(wsl, l, item);
#pragma unroll
            for (int g = 0; g < 4; ++g) {
                const int n = ACCBASE(mi, g, fh);
                const f32x4 o = hld4(lds + (wave < 4 ? HSLOT(1) : GSLOT(4)), HS, t, n);
                if (wave < 4) { uint2 w; w.x = pack2(acc[4 * g] + o[0], acc[4 * g + 1] + o[1]); w.y = pack2(acc[4 * g + 2] + o[2], acc[4 * g + 3] + o[3]); *(uint2*)(Q1g + t * 64 + n) = w; }
                else hst4(lds + HSLOT(0), HS, t, n, acc[4 * g] + o[0], acc[4 * g + 1] + o[1], acc[4 * g + 2] + o[2], acc[4 * g + 3] + o[3]);
            }
        }
        {
            const int w4 = wave & 3, mi = w4 >> 1, ni = w4 & 1, fr = lane & 31, fh = lane >> 5;
            const f32x16 acc = mm32<4>(lds + (wave < 4 ? GSLOT(0) : GSLOT(1)), HS, lds + HSLOT(5), HS, mi, ni, lane, zero16());
            const int jo = ni * 32 + fr;
            const float pc = PC[jo];
            if (wave < 4) {
                bf16_t* F1g = (bf16_t*)(wsl + WS_F1) + (size_t)(bh * NCH + c) * 4096;
                const int mt = jo >> 4, row = jo & 15;
#pragma unroll
                for (int g = 0; g < 4; ++g) {
                    const int nb = ACCBASE(mi, g, fh);
                    const int ks = nb >> 5, jj = nb & 31, hi = jj >> 4, qq = (jj & 15) >> 2;
                    uint2 o;
                    o.x = pack2(pc * (acc[4 * g] + (jo == nb ? 1.f : 0.f)), pc * (acc[4 * g + 1] + (jo == nb + 1 ? 1.f : 0.f)));
                    o.y = pack2(pc * (acc[4 * g + 2] + (jo == nb + 2 ? 1.f : 0.f)), pc * (acc[4 * g + 3] + (jo == nb + 3 ? 1.f : 0.f)));
                    *(uint2*)(F1g + (((mt * 2 + ks) * 64 + qq * 16 + row) * 8) + hi * 4) = o;
                }
            } else {
#pragma unroll
                for (int g = 0; g < 4; ++g) {
                    const int sI = ACCBASE(mi, g, fh);
                    hst4(lds + GSLOT(6), HS, jo, sI, pc * (acc[4 * g] + hld(lds + HSLOT(3), sI, jo)), pc * (acc[4 * g + 1] + hld(lds + HSLOT(3), sI + 1, jo)),
                         pc * (acc[4 * g + 2] + hld(lds + HSLOT(3), sI + 2, jo)), pc * (acc[4 * g + 3] + hld(lds + HSLOT(3), sI + 3, jo)));
                }
            }
        }
        __syncthreads();
        if (wave >= 4) {
            const int w4 = wave - 4, mi = w4 >> 1, ni = w4 & 1, fr = lane & 31, fh = lane >> 5;
            const f32x16 acc = mm32<4>(lds + HSLOT(6), HS, lds + HSLOT(0), HS, mi, ni, lane, zero16());
            const int t = ni * 32 + fr;
#pragma unroll
            for (int g = 0; g < 4; ++g) {
                uint2 w; w.x = pack2(acc[4 * g], acc[4 * g + 1]); w.y = pack2(acc[4 * g + 2], acc[4 * g + 3]);
                *(uint2*)(ymix + (g0 + t) * 1024 + h * 64 + ACCBASE(mi, g, fh)) = w;
            }
        }
        if (wave < 4) {
            const int mi = wave >> 1, ni = wave & 1, fr = lane & 31, fh = lane >> 5;
            const f32x16 acc = mm32<4>(lds + GSLOT(6), HS, lds + HSLOT(6), HS, mi, ni, lane, zero16());
            bf16_t* Zg = (bf16_t*)(wsl + WS_ZS) + (size_t)(bh * NCH + c) * 4096;
            const int i = ni * 32 + fr, vg = i >> 4, n = i & 15;
#pragma unroll
            for (int g = 0; g < 4; ++g) {
                const int jb = ACCBASE(mi, g, fh), mt = jb >> 4, qq = (jb & 15) >> 2;
                uint2 o; o.x = pack2(acc[4 * g], acc[4 * g + 1]); o.y = pack2(acc[4 * g + 2], acc[4 * g + 3]);
                *(uint2*)(Zg + (((vg * 4 + mt) * 64 + qq * 16 + n) * 4)) = o;
            }
        }
        __syncthreads();
    } else {
        {
            const int w4 = wave & 3, mi = w4 >> 1, ni = w4 & 1, fr = lane & 31, fh = lane >> 5;
            const f32x16 acc = mm32<4>(lds + (wave < 4 ? GSLOT(0) : GSLOT(1)), HS, lds + GSLOT(3), HS, mi, ni, lane, zero16());
            const int t = ni * 32 + fr;
#pragma unroll
            for (int g = 0; g < 4; ++g) {
                const int n = ACCBASE(mi, g, fh);
                const f32x4 o = hld4(lds + (wave < 4 ? HSLOT(1) : GSLOT(4)), HS, t, n);
                hst4(lds + (wave < 4 ? GSLOT(6) : HSLOT(0)), HS, t, n, acc[4 * g] + o[0], acc[4 * g + 1] + o[1], acc[4 * g + 2] + o[2], acc[4 * g + 3] + o[3]);
            }
            *(LAS u32x4*)(lds + GSLOT(5) + (tid >> 3) * HS + (tid & 7) * 16) = s0pref;
        }
        __syncthreads();
        if (wave < 4) {
            const int mi = wave >> 1, ni = wave & 1, fr = lane & 31, fh = lane >> 5;
            f32x16 acc = mm32<4>(lds + GSLOT(5), HS, lds + GSLOT(6), HS, mi, ni, lane, zero16());
            acc = mm32<4>(lds + HSLOT(6), HS, lds + HSLOT(0), HS, mi, ni, lane, acc);
            LAS float* YF = (LAS float*)(lds + L_YF);
            const int t = ni * 32 + fr;
#pragma unroll
            for (int g = 0; g < 4; ++g) *(LAS f32x4*)(YF + t * FS + ACCBASE(mi, g, fh)) = (f32x4){acc[4 * g], acc[4 * g + 1], acc[4 * g + 2], acc[4 * g + 3]};
        } else {
            const int u = tid - 256;
#pragma unroll
            for (int ii = 0; ii < 4; ++ii) {
                const int e = u + 256 * ii, t = e >> 4, q8 = e & 15;
                float cf[8], pf[8]; unpack8(gcw[ii], cf); unpack8(gpw[ii], pf);
                float g[8];
#pragma unroll
                for (int i = 0; i < 8; ++i) g[i] = sigmoidf_(cf[i] + (pf[i] - cf[i]) * CST[C_MUG + q8 * 8 + i]);
                u32x4 o; o[0] = pack2(g[0], g[1]); o[1] = pack2(g[2], g[3]); o[2] = pack2(g[4], g[5]); o[3] = pack2(g[6], g[7]);
                *(LAS u32x4*)(lds + GSLOT(0) + t * 272 + q8 * 16) = o;
                *(LAS u32x4*)(lds + HSLOT(1) + t * 272 + q8 * 16) = hw.g2[ii];
            }
        }
        __syncthreads();
        if (wave < 4) {
            const int mi = wave >> 1, ni = wave & 1, fr = lane & 31, fh = lane >> 5;
            const f32x16 acc = mm32<8>(lds + HSLOT(1), 272, lds + GSLOT(0), 272, mi, ni, lane, zero16());
            LAS float* GF = (LAS float*)(lds + L_GF);
            const int t = ni * 32 + fr;
#pragma unroll
            for (int g = 0; g < 4; ++g) *(LAS f32x4*)(GF + t * FS + ACCBASE(mi, g, fh)) = (f32x4){acc[4 * g], acc[4 * g + 1], acc[4 * g + 2], acc[4 * g + 3]};
        }
        __syncthreads();
        {
            const int t = pt, q = pq;
            LAS float* YF = (LAS float*)(lds + L_YF); LAS float* GF = (LAS float*)(lds + L_GF);
            float yv[8], gv[8], vv[8]; float sm = 0.f;
            {
                const f32x4 y0 = *(LAS f32x4*)(YF + t * FS + q * 8), y1 = *(LAS f32x4*)(YF + t * FS + q * 8 + 4);
                const f32x4 gg0 = *(LAS f32x4*)(GF + t * FS + q * 8), gg1 = *(LAS f32x4*)(GF + t * FS + q * 8 + 4);
                const f32x4 v0v = *(LAS f32x4*)(V + t * FS + q * 8), v1v = *(LAS f32x4*)(V + t * FS + q * 8 + 4);
#pragma unroll
                for (int i = 0; i < 4; ++i) { yv[i] = y0[i]; yv[4 + i] = y1[i]; gv[i] = gg0[i]; gv[4 + i] = gg1[i]; vv[i] = v0v[i]; vv[4 + i] = v1v[i]; }
            }
#pragma unroll
            for (int i = 0; i < 8; ++i) sm += yv[i];
            sm = grp8_sum(sm);
            const float mean = sm * (1.0f / 64.f);
            float vr = 0.f;
#pragma unroll
            for (int i = 0; i < 8; ++i) { const float d = yv[i] - mean; vr += d * d; }
            vr = grp8_sum(vr);
            const float istd = __builtin_amdgcn_rsqf(vr * (1.0f / 64.f) + GN_EPS);
            const float beta = BETA[t];
            float o[8];
#pragma unroll
            for (int i = 0; i < 8; ++i) { const int j = q * 8 + i; o[i] = ((yv[i] - mean) * istd * CST[C_LNG + j] + CST[C_LNB + j] + beta * vv[i]) * gv[i]; }
            u32x4 ow; ow[0] = pack2(o[0], o[1]); ow[1] = pack2(o[2], o[3]); ow[2] = pack2(o[4], o[5]); ow[3] = pack2(o[6], o[7]);
            *(u32x4*)(ymix + (g0 + t) * 1024 + h * 64 + q * 8) = ow;
        }
        __syncthreads();
    }
}

struct DPre { u32x4 q1, s0, gc[2], gp[2], y2, vv; float beta; };
__device__ __forceinline__ void dpre_load(unsigned char* ws, int l, int item, int tid, DPre& d) {
    const int bh = item & 31, c = item >> 5, b = bh >> 3, h = bh & 7, pt = tid >> 3, pq = tid & 7;
    const size_t g0 = (size_t)b * SEQ + (size_t)c * 64;
    d.q1 = *(const u32x4*)(q1_ptr(ws, l, item) + tid * 8);
    d.s0 = *(const u32x4*)((const bf16_t*)(ws + WS_ZS) + (size_t)(bh * NCH + c) * 4096 + tid * 8);
    const bf16_t* z = (const bf16_t*)(ws + WS_Z);
#pragma unroll
    for (int i = 0; i < 2; ++i) {
        const int e = tid + 512 * i, t = e >> 4, q8 = e & 15;
        const bf16_t* zcc = z + (g0 + t) * ZC + 1664 + q8 * 8;
        d.gc[i] = *(const u32x4*)zcc;
        d.gp[i] = (u32x4){0u, 0u, 0u, 0u};
        if (!(c == 0 && t == 0)) d.gp[i] = *(const u32x4*)(zcc - ZC);
    }
    d.y2 = *(const u32x4*)((const bf16_t*)(ws + WS_YMIX) + (g0 + pt) * 1024 + h * 64 + pq * 8);
    d.vv = *(const u32x4*)((const bf16_t*)(ws + WS_VFIRST) + (g0 + pt) * 512 + h * 64 + pq * 8);
    d.beta = ((const float*)(ws + WS_BETA))[(size_t)item * 64 + pt];
}
__device__ void rwkv_out(const Params& p, int l, int item, ldsp lds, const DPre& dcur, DPre& dnext, int item_next, const HeadW& hw) {
    int tid = threadIdx.x;
    asm volatile("" : "+v"(tid));
    const int lane = tid & 63, wave = __builtin_amdgcn_readfirstlane(tid >> 6);
    unsigned char* wsl = ptr_opaque(p.ws);
    const int bh = item & 31, c = item >> 5, b = bh >> 3, h = bh & 7;
    const size_t g0 = (size_t)b * SEQ + (size_t)c * 64;
    bf16_t* ymix = (bf16_t*)(wsl + WS_YMIX);
    LAS float* CST = (LAS float*)(lds + L_CST);
    if (item_next >= 0) dpre_load(wsl, l, item_next, tid, dnext);
    *(LAS u32x4*)(lds + GSLOT(6) + (tid >> 3) * HS + (tid & 7) * 16) = dcur.q1;
    *(LAS u32x4*)(lds + GSLOT(5) + (tid >> 3) * HS + (tid & 7) * 16) = dcur.s0;
#pragma unroll
    for (int ii = 0; ii < 2; ++ii) {
        const int e = tid + 512 * ii, t = e >> 4, q8 = e & 15;
        float cf[8], pf[8]; unpack8(dcur.gc[ii], cf); unpack8(dcur.gp[ii], pf);
        float g[8];
#pragma unroll
        for (int i = 0; i < 8; ++i) g[i] = sigmoidf_(cf[i] + (pf[i] - cf[i]) * CST[C_MUG + q8 * 8 + i]);
        u32x4 o; o[0] = pack2(g[0], g[1]); o[1] = pack2(g[2], g[3]); o[2] = pack2(g[4], g[5]); o[3] = pack2(g[6], g[7]);
        *(LAS u32x4*)(lds + GSLOT(0) + t * 272 + q8 * 16) = o;
        *(LAS u32x4*)(lds + HSLOT(1) + t * 272 + q8 * 16) = hw.g2[ii];
    }
    __syncthreads();
    {
        const int w4 = wave & 3, mi = w4 >> 1, ni = w4 & 1, fr = lane & 31, fh = lane >> 5;
        const int t = ni * 32 + fr;
        if (wave < 4) {
            const f32x16 acc = mm32<4>(lds + GSLOT(5), HS, lds + GSLOT(6), HS, mi, ni, lane, zero16());
            LAS float* YF = (LAS float*)(lds + L_YF);
#pragma unroll
            for (int g = 0; g < 4; ++g) *(LAS f32x4*)(YF + t * FS + ACCBASE(mi, g, fh)) = (f32x4){acc[4 * g], acc[4 * g + 1], acc[4 * g + 2], acc[4 * g + 3]};
        } else {
            const f32x16 acc = mm32<8>(lds + HSLOT(1), 272, lds + GSLOT(0), 272, mi, ni, lane, zero16());
            LAS float* GF = (LAS float*)(lds + L_GF);
#pragma unroll
            for (int g = 0; g < 4; ++g) *(LAS f32x4*)(GF + t * FS + ACCBASE(mi, g, fh)) = (f32x4){acc[4 * g], acc[4 * g + 1], acc[4 * g + 2], acc[4 * g + 3]};
        }
    }
    __syncthreads();
    {
        const int t = tid >> 3, q = tid & 7;
        LAS float* YF = (LAS float*)(lds + L_YF); LAS float* GF = (LAS float*)(lds + L_GF);
        float yv[8], gv[8], vv[8], y2[8]; float sm = 0.f;
        unpack8(dcur.y2, y2); unpack8(dcur.vv, vv);
        {
            const f32x4 y0 = *(LAS f32x4*)(YF + t * FS + q * 8), y1 = *(LAS f32x4*)(YF + t * FS + q * 8 + 4);
            const f32x4 gg0 = *(LAS f32x4*)(GF + t * FS + q * 8), gg1 = *(LAS f32x4*)(GF + t * FS + q * 8 + 4);
#pragma unroll
            for (int i = 0; i < 4; ++i) { yv[i] = y0[i] + y2[i]; yv[4 + i] = y1[i] + y2[4 + i]; gv[i] = gg0[i]; gv[4 + i] = gg1[i]; }
        }
#pragma unroll
        for (int i = 0; i < 8; ++i) sm += yv[i];
        sm = grp8_sum(sm);
        const float mean = sm * (1.0f / 64.f);
        float vr = 0.f;
#pragma unroll
        for (int i = 0; i < 8; ++i) { const float d = yv[i] - mean; vr += d * d; }
        vr = grp8_sum(vr);
        const float istd = __builtin_amdgcn_rsqf(vr * (1.0f / 64.f) + GN_EPS);
        const float beta = dcur.beta;
        float o[8];
#pragma unroll
        for (int i = 0; i < 8; ++i) { const int j = q * 8 + i; o[i] = ((yv[i] - mean) * istd * CST[C_LNG + j] + CST[C_LNB + j] + beta * vv[i]) * gv[i]; }
        u32x4 ow; ow[0] = pack2(o[0], o[1]); ow[1] = pack2(o[2], o[3]); ow[2] = pack2(o[4], o[5]); ow[3] = pack2(o[6], o[7]);
        *(u32x4*)(ymix + (g0 + t) * 1024 + h * 64 + q * 8) = ow;
    }
    __syncthreads();
}

__device__ void rwkv_scan(const Params& p, int bh, int vg) {
    const int lane = tid_opaque() & 63;
    const bf16_t* F1 = (const bf16_t*)(p.ws + WS_F1) + (size_t)bh * NCH * 4096;
    bf16_t* ZS = (bf16_t*)(p.ws + WS_ZS) + (size_t)bh * NCH * 4096;
    const int n = lane & 15, q = lane >> 4;
    bf16x8 xs[2];
#pragma unroll
    for (int ks = 0; ks < 2; ++ks)
#pragma unroll
        for (int j = 0; j < 8; ++j) xs[ks][j] = 0;
#pragma unroll 1
    for (int c = 0; c < NCH; ++c) {
        bf16x8 af[4][2];
#pragma unroll
        for (int mt = 0; mt < 4; ++mt)
#pragma unroll
            for (int ks = 0; ks < 2; ++ks) af[mt][ks] = *(const bf16x8*)(F1 + (size_t)c * 4096 + ((mt * 2 + ks) * 64 + lane) * 8);
        f32x4 acc[4];
#pragma unroll
        for (int mt = 0; mt < 4; ++mt) {
            const uint2 zw = *(const uint2*)(ZS + (size_t)c * 4096 + ((vg * 4 + mt) * 64 + lane) * 4);
            acc[mt][0] = bflo(zw.x); acc[mt][1] = bfhi(zw.x); acc[mt][2] = bflo(zw.y); acc[mt][3] = bfhi(zw.y);
        }
#pragma unroll
        for (int mt = 0; mt < 4; ++mt)
#pragma unroll
            for (int ks = 0; ks < 2; ++ks) acc[mt] = __builtin_amdgcn_mfma_f32_16x16x32_bf16(af[mt][ks], xs[ks], acc[mt], 0, 0, 0);
#pragma unroll
        for (int ks = 0; ks < 2; ++ks)
#pragma unroll
            for (int hi = 0; hi < 2; ++hi) {
                uint2 o;
                o.x = (unsigned)(unsigned short)xs[ks][hi * 4 + 0] | ((unsigned)(unsigned short)xs[ks][hi * 4 + 1] << 16);
                o.y = (unsigned)(unsigned short)xs[ks][hi * 4 + 2] | ((unsigned)(unsigned short)xs[ks][hi * 4 + 3] << 16);
                *(uint2*)(ZS + (size_t)c * 4096 + (vg * 16 + n) * 64 + ks * 32 + hi * 16 + q * 4) = o;
            }
#pragma unroll
        for (int ks = 0; ks < 2; ++ks)
#pragma unroll
            for (int j = 0; j < 8; ++j) xs[ks][j] = (short)f2bf(acc[ks * 2 + (j >> 2)][j & 3]);
    }
}

__device__ void rwkv_scan_ring(const Params& p, int bh, ldsp lds, bool st) {
    const int tid = tid_opaque(), lane = tid & 63, wave = __builtin_amdgcn_readfirstlane(tid >> 6);
    unsigned char* wsl = ptr_opaque(p.ws);
    const unsigned char* F1 = wsl + WS_F1 + (size_t)bh * NCH * 8192;
    unsigned char* ZS = wsl + WS_ZS + (size_t)bh * NCH * 8192;
    constexpr int D = 6, SLOT = 16384;
    const int lw = wave - 4, vg = wave;
    const int n = lane & 15, q = lane >> 4;
#define SCAN_ISSUE(c_) do { const int sl_ = (c_) & 7; \
        _Pragma("unroll") for (int j = 0; j < 2; ++j) { \
            __builtin_amdgcn_global_load_lds((const unsigned*)(F1 + (size_t)(c_) * 8192 + lw * 2048 + j * 1024 + lane * 16), (LAS unsigned*)(lds + sl_ * SLOT + lw * 2048 + j * 1024), 16, 0, 0); \
            __builtin_amdgcn_global_load_lds((const unsigned*)(ZS + (size_t)(c_) * 8192 + lw * 2048 + j * 1024 + lane * 16), (LAS unsigned*)(lds + sl_ * SLOT + 8192 + lw * 2048 + j * 1024), 16, 0, 0); } } while (0)
    if (wave >= 4) {
#pragma unroll 1
        for (int c = 0; c < D; ++c) SCAN_ISSUE(c);
    }
    bf16x8 xs[2];
#pragma unroll
    for (int ks = 0; ks < 2; ++ks)
#pragma unroll
        for (int j = 0; j < 8; ++j) xs[ks][j] = 0;
#pragma unroll 1
    for (int c = 0; c < NCH; ++c) {
        if (wave >= 4) {
            if (c + D < NCH) { SCAN_ISSUE(c + D); asm volatile("s_waitcnt vmcnt(24)" ::: "memory"); }
            else asm volatile("s_waitcnt vmcnt(0)" ::: "memory");
        }
        asm volatile("s_waitcnt lgkmcnt(0)" ::: "memory");
        __builtin_amdgcn_s_barrier();
        if (wave < 4) {
            ldsp slot = lds + (c & 7) * SLOT;
            f32x4 acc[4];
#pragma unroll
            for (int mt = 0; mt < 4; ++mt) {
                using u32x2 = __attribute__((ext_vector_type(2))) unsigned;
                const u32x2 zw = *(LAS u32x2*)(slot + 8192 + ((vg * 4 + mt) * 64 + lane) * 8);
                acc[mt][0] = bflo(zw[0]); acc[mt][1] = bfhi(zw[0]); acc[mt][2] = bflo(zw[1]); acc[mt][3] = bfhi(zw[1]);
            }
            bf16x8 af[8];
#pragma unroll
            for (int i = 0; i < 8; ++i) af[i] = *(LAS bf16x8*)(slot + (i * 64 + lane) * 16);
            __builtin_amdgcn_sched_group_barrier(0x100, 8, 0);
#pragma unroll
            for (int ks = 0; ks < 2; ++ks)
#pragma unroll
                for (int mt = 0; mt < 4; ++mt) acc[mt] = __builtin_amdgcn_mfma_f32_16x16x32_bf16(af[mt * 2 + ks], xs[ks], acc[mt], 0, 0, 0);
            __builtin_amdgcn_sched_group_barrier(0x008, 8, 0);
#pragma unroll
            for (int ks = 0; ks < 2; ++ks)
#pragma unroll
                for (int hi = 0; hi < 2; ++hi) {
                    uint2 o;
                    o.x = (unsigned)(unsigned short)xs[ks][hi * 4 + 0] | ((unsigned)(unsigned short)xs[ks][hi * 4 + 1] << 16);
                    o.y = (unsigned)(unsigned short)xs[ks][hi * 4 + 2] | ((unsigned)(unsigned short)xs[ks][hi * 4 + 3] << 16);
                    if (st) *(uint2*)((bf16_t*)ZS + (size_t)c * 4096 + (vg * 16 + n) * 64 + ks * 32 + hi * 16 + q * 4) = o;
                }
#pragma unroll
            for (int ks = 0; ks < 2; ++ks)
#pragma unroll
                for (int j = 0; j < 8; ++j) xs[ks][j] = (short)f2bf(acc[ks * 2 + (j >> 2)][j & 3]);
        }
    }
#undef SCAN_ISSUE
}

constexpr int S5_WLDS = 4096 + 3072 + 32 * 272;
__device__ void s5_chunk(const Params& p, int l, int wi, int mode, ldsp lds) {
    int tid = threadIdx.x;
    asm volatile("" : "+v"(tid));
    const int lane = tid & 63, wave = __builtin_amdgcn_readfirstlane(tid >> 6);
    unsigned char* wsl = ptr_opaque(p.ws);
    const int bg = wi >> 7, c = wi & 127;
    const int b = bg >> 5, g = bg & 31;
    unsigned char* W = (wsl + WS_WT + (size_t)(l) * WT_LAYER);
    const bf16_t* z = (const bf16_t*)(wsl + WS_Z);
    bf16_t* ymix = (bf16_t*)(wsl + WS_YMIX);
    float2* SE = (float2*)(wsl + WS_SE) + ((size_t)bg * NCH + c) * 64 + lane;
    LAS float* U = (LAS float*)(lds + wave * S5_WLDS);
    ldsp Ub = lds + wave * S5_WLDS + 4096;
    ldsp X = lds + wave * S5_WLDS + 4096 + 3072;
    const int fr = lane & 31, fh = lane >> 5;
    bf16x8 bq[4];
    {
        const bf16_t* bb2 = (const bf16_t*)(W + WO_BB2) + ((size_t)g * 128 + fr) * 16 + fh * 8;
#pragma unroll
        for (int mi = 0; mi < 4; ++mi) bq[mi] = *(const bf16x8*)(bb2 + mi * 32 * 16);
    }
    const float4 lam = *(const float4*)((const float*)(W + WO_LAM) + ((size_t)g * 64 + lane) * 4);
    const float lbre = lam.x, lbim = lam.y;
    float xre = 0.f, xim = 0.f;
    if (mode == 1) { const float2 sv = *SE; xre = sv.x; xim = sv.y; }
    const size_t g0 = (size_t)b * SEQ + (size_t)c * 64;
    {
        const u32x4* src = (const u32x4*)(z + (g0 + lane) * ZC + 1792 + g * 16);
        const u32x4 a = src[0], bqv = src[1];
        *(LAS u32x4*)(Ub + lane * 48) = a; *(LAS u32x4*)(Ub + lane * 48 + 16) = bqv;
        if (mode == 1) {
            float f[8];
            unpack8(a, f);
            *(LAS f32x4*)(U + lane * 16) = (f32x4){f[0], f[1], f[2], f[3]}; *(LAS f32x4*)(U + lane * 16 + 4) = (f32x4){f[4], f[5], f[6], f[7]};
            unpack8(bqv, f);
            *(LAS f32x4*)(U + lane * 16 + 8) = (f32x4){f[0], f[1], f[2], f[3]}; *(LAS f32x4*)(U + lane * 16 + 12) = (f32x4){f[4], f[5], f[6], f[7]};
        }
    }
    asm volatile("s_waitcnt lgkmcnt(0)" ::: "memory");
    bf16x8 cf[4];
    float dsk = 0.f;
    if (mode == 1) {
        const bf16_t* cm = (const bf16_t*)(W + WO_CMAT) + (size_t)g * 16 * 128 + (lane & 15) * 128 + (lane >> 4) * 8;
#pragma unroll
        for (int kk = 0; kk < 4; ++kk) cf[kk] = *(const bf16x8*)(cm + kk * 32);
        dsk = p.in[I_S5D][l * 512 + g * 16 + (lane & 15)];
    }
#pragma unroll 1
    for (int sub = 0; sub < 2; ++sub) {
        {
            const bf16x8 yf = *(LAS bf16x8*)(Ub + (sub * 32 + fr) * 48 + fh * 16);
            f32x16 accs[4];
#pragma unroll
            for (int mi = 0; mi < 4; ++mi) accs[mi] = __builtin_amdgcn_mfma_f32_32x32x16_bf16(bq[mi], yf, zero16(), 0, 0, 0);
            __builtin_amdgcn_sched_group_barrier(0x008, 4, 0);
#pragma unroll
            for (int mi = 0; mi < 4; ++mi)
#pragma unroll
                for (int gq = 0; gq < 4; ++gq) hst4(X, 272, fr, ACCBASE(mi, gq, fh), accs[mi][4 * gq], accs[mi][4 * gq + 1], accs[mi][4 * gq + 2], accs[mi][4 * gq + 3]);
        }
        asm volatile("s_waitcnt lgkmcnt(0)" ::: "memory");
#pragma unroll 1
        for (int t0 = 0; t0 < 32; t0 += 16) {
            unsigned wv[16];
#pragma unroll
            for (int i = 0; i < 16; ++i) wv[i] = *(LAS unsigned*)(X + (t0 + i) * 272 + lane * 4);
#pragma unroll
            for (int i = 0; i < 16; ++i) {
                const float nr = lbre * xre - lbim * xim + bflo(wv[i]);
                const float ni = lbre * xim + lbim * xre + bfhi(wv[i]);
                xre = nr; xim = ni;
                if (mode == 1) *(LAS unsigned*)(X + (t0 + i) * 272 + lane * 4) = pack2(xre, xim);
            }
        }
        asm volatile("s_waitcnt lgkmcnt(0)" ::: "memory");
        if (mode == 1) {
            bf16x8 xa[2][4];
#pragma unroll
            for (int mi = 0; mi < 2; ++mi)
#pragma unroll
                for (int kk = 0; kk < 4; ++kk) xa[mi][kk] = *(LAS bf16x8*)(X + (mi * 16 + (lane & 15)) * 272 + (kk * 32 + (lane >> 4) * 8) * 2);
            __builtin_amdgcn_sched_group_barrier(0x100, 8, 0);
            f32x4 acc2[2] = {{0.f, 0.f, 0.f, 0.f}, {0.f, 0.f, 0.f, 0.f}};
#pragma unroll
            for (int kk = 0; kk < 4; ++kk)
#pragma unroll
                for (int mi = 0; mi < 2; ++mi) acc2[mi] = __builtin_amdgcn_mfma_f32_16x16x32_bf16(xa[mi][kk], cf[kk], acc2[mi], 0, 0, 0);
            __builtin_amdgcn_sched_group_barrier(0x008, 8, 0);
#pragma unroll
            for (int mi = 0; mi < 2; ++mi) {
                const f32x4 acc = acc2[mi];
#pragma unroll
                for (int r = 0; r < 4; ++r) {
                    const int t = sub * 32 + mi * 16 + (lane >> 4) * 4 + r, cc = lane & 15;
                    const float y = acc[r] + dsk * U[t * 16 + cc];
                    ymix[(g0 + t) * 1024 + 512 + g * 16 + cc] = f2bf(gelu_(y));
                }
            }
            asm volatile("s_waitcnt lgkmcnt(0)" ::: "memory");
        }
    }
    if (mode == 0) *SE = make_float2(xre, xim);
}

__device__ void phase_bd(const Params& p, int l, int mode, ldsp lds) {
    const int bid = bid_opaque(), G = gridDim.x, wave = tid_opaque() >> 6;
    if (mode == 0) {
        ZPre za, zb;
        HeadW hw;
        int cur_bh = -1;
        zpre_load(p.ws, bid, tid_opaque(), za, l);
#pragma unroll 1
        for (int it = bid; it < 32 * NCH; it += G) {
            if ((it & 31) != cur_bh) { cur_bh = it & 31; __syncthreads(); head_consts_load(p, l, cur_bh & 7, tid_opaque(), lds, hw, 0); }
            rwkv_chunk(p, l, it, 0, lds, za, zb, (it + G < 32 * NCH) ? it + G : -1, hw);
            za = zb;
        }
    } else {
        DPre da, db;
        HeadW hw;
        int cur_bh = -1;
        dpre_load(p.ws, l, bid, tid_opaque(), da);
#pragma unroll 1
        for (int it = bid; it < 32 * NCH; it += G) {
            if ((it & 31) != cur_bh) { cur_bh = it & 31; __syncthreads(); head_consts_load(p, l, cur_bh & 7, tid_opaque(), lds, hw, 1); }
            rwkv_out(p, l, it, lds, da, db, (it + G < 32 * NCH) ? it + G : -1, hw);
            da = db;
        }
    }
    __syncthreads();
#pragma unroll 1
    for (int s5rep = 0; s5rep < ((PROBE & 8388608) ? 2 : 1); ++s5rep)
#pragma unroll 1
    for (int it = bid; it < 2048; it += G) s5_chunk(p, l, it * 8 + wave, mode, lds);
}

__device__ void phase_c(const Params& p, int l, ldsp lds, bool st) {
    const int bid = bid_opaque(), G = gridDim.x, tid = tid_opaque(), wave = tid >> 6;
    if (bid < 32) rwkv_scan_ring(p, bid, lds, st);
    else if (bid < 48) {
        const int idx = (bid - 32) * NTHREADS + tid, bg = idx >> 6, pp = idx & 63, g = bg & 31;
        const float4 lam = *(const float4*)((const float*)(wt_layer(p, l) + WO_LAM) + ((size_t)g * 64 + pp) * 4);
        float2* SE = (float2*)(p.ws + WS_SE) + (size_t)bg * NCH * 64 + pp;
        float cr = 0.f, ci = 0.f;
#pragma unroll 1
        for (int c0 = 0; c0 < NCH; c0 += 16) {
            float2 e[16];
#pragma unroll
            for (int i = 0; i < 16; ++i) e[i] = SE[(c0 + i) * 64];
#pragma unroll
            for (int i = 0; i < 16; ++i) {
                if (st) SE[(c0 + i) * 64] = make_float2(cr, ci);
                const float nr = lam.z * cr - lam.w * ci + e[i].x, ni = lam.z * ci + lam.w * cr + e[i].y;
                cr = nr; ci = ni;
            }
        }
    }
    else convert_tables(p, l, bid - 48, G - 48);
}

#ifndef ESUB
#define ESUB 0xff
#endif
constexpr int L_SSQ = LDS_TOTAL - 2048;
constexpr int L_RSN = LDS_TOTAL - 1536;
constexpr int L_TK = 128 * 132 * 4;

__device__ __forceinline__ int f2key(float f, int payload, int mask) { int u = __float_as_int(f); u = (u & ~mask) | payload; return u ^ ((u >> 31) & 0x7fffffff); }
__device__ __forceinline__ int key2u(int k) { return k ^ ((k >> 31) & 0x7fffffff); }
__device__ __forceinline__ void ce_desc(int& a, int& b) { const int mx = max(a, b), mn = min(a, b); a = mx; b = mn; }
__device__ __forceinline__ void sort16_desc(int* v) {
    ce_desc(v[0], v[13]); ce_desc(v[1], v[12]); ce_desc(v[2], v[15]); ce_desc(v[3], v[14]); ce_desc(v[4], v[8]); ce_desc(v[5], v[6]); ce_desc(v[7], v[11]); ce_desc(v[9], v[10]);
    ce_desc(v[0], v[5]); ce_desc(v[1], v[7]); ce_desc(v[2], v[9]); ce_desc(v[3], v[4]); ce_desc(v[6], v[13]); ce_desc(v[8], v[14]); ce_desc(v[10], v[15]); ce_desc(v[11], v[12]);
    ce_desc(v[0], v[1]); ce_desc(v[2], v[3]); ce_desc(v[4], v[5]); ce_desc(v[6], v[8]); ce_desc(v[7], v[9]); ce_desc(v[10], v[11]); ce_desc(v[12], v[13]); ce_desc(v[14], v[15]);
    ce_desc(v[0], v[2]); ce_desc(v[1], v[3]); ce_desc(v[4], v[10]); ce_desc(v[5], v[11]); ce_desc(v[6], v[7]); ce_desc(v[8], v[9]); ce_desc(v[12], v[14]); ce_desc(v[13], v[15]);
    ce_desc(v[1], v[2]); ce_desc(v[3], v[12]); ce_desc(v[4], v[6]); ce_desc(v[5], v[7]); ce_desc(v[8], v[10]); ce_desc(v[9], v[11]); ce_desc(v[13], v[14]);
    ce_desc(v[1], v[4]); ce_desc(v[2], v[6]); ce_desc(v[5], v[8]); ce_desc(v[7], v[10]); ce_desc(v[9], v[13]); ce_desc(v[11], v[14]);
    ce_desc(v[2], v[4]); ce_desc(v[3], v[6]); ce_desc(v[9], v[12]); ce_desc(v[11], v[13]);
    ce_desc(v[3], v[5]); ce_desc(v[6], v[8]); ce_desc(v[7], v[9]); ce_desc(v[10], v[12]);
    ce_desc(v[3], v[4]); ce_desc(v[5], v[6]); ce_desc(v[7], v[8]); ce_desc(v[9], v[10]); ce_desc(v[11], v[12]);
    ce_desc(v[6], v[7]); ce_desc(v[8], v[9]);
}
__device__ __forceinline__ void merge16_desc(int* A, const int* B) {
#pragma unroll
    for (int i = 0; i < 16; ++i) A[i] = max(A[i], B[15 - i]);
#pragma unroll
    for (int j = 8; j > 0; j >>= 1)
#pragma unroll
        for (int i = 0; i < 16; ++i) if ((i & j) == 0) ce_desc(A[i], A[i | j]);
}

__device__ __forceinline__ void xadd_rowpass_f(ldsp lds, float* x, int row0, int col0, int lane, int wave, bool xw = true) {
    TILE_ROWS4(r0) {
        f32x4 v[4]; float4 xv[4];
#pragma unroll
        for (int u = 0; u < 4; ++u) { v[u] = tile4(lds, r0 + 8 * u, lane); xv[u] = *(const float4*)(x + (size_t)(row0 + r0 + 8 * u) * DM + col0 + lane * 4); }
        __builtin_amdgcn_sched_group_barrier(0x100, 4, 0);
#pragma unroll
        for (int u = 0; u < 4; ++u) {
            xv[u].x += v[u][0]; xv[u].y += v[u][1]; xv[u].z += v[u][2]; xv[u].w += v[u][3];
            if (xw) *(float4*)(x + (size_t)(row0 + r0 + 8 * u) * DM + col0 + lane * 4) = xv[u];
        }
    }
}
__device__ __forceinline__ void xadd_rowpass_i(ldsp lds, float* x, const float* sw, int row0, int col0, int lane, int wave, bool xw = true) {
    LAS float* sal = (LAS float*)(lds + L_SAL);
    const float4 w4 = *(const float4*)(sw + col0 + lane * 4);
    TILE_ROWS4(r0) {
        f32x4 v[4]; float sa[4]; float4 xv[4];
#pragma unroll
        for (int u = 0; u < 4; ++u) { v[u] = tile4i(lds, r0 + 8 * u, lane); sa[u] = sal[r0 + 8 * u]; xv[u] = *(const float4*)(x + (size_t)(row0 + r0 + 8 * u) * DM + col0 + lane * 4); }
        __builtin_amdgcn_sched_group_barrier(0x100, 8, 0);
#pragma unroll
        for (int u = 0; u < 4; ++u) {
            xv[u].x += v[u][0] * sa[u] * w4.x; xv[u].y += v[u][1] * sa[u] * w4.y; xv[u].z += v[u][2] * sa[u] * w4.z; xv[u].w += v[u][3] * sa[u] * w4.w;
            if (xw) *(float4*)(x + (size_t)(row0 + r0 + 8 * u) * DM + col0 + lane * 4) = xv[u];
        }
    }
}
__device__ __forceinline__ void quant_rows_bf16(const bf16_t* src, int ld, unsigned char* dst, ldsp lds, int lane, int wave) {
    LAS float* sal = (LAS float*)(lds + L_SAL);
    TILE_ROWS4(r0) {
        u32x4 av[4], bv[4];
#pragma unroll
        for (int u = 0; u < 4; ++u) { av[u] = *(const u32x4*)(src + (size_t)(r0 + 8 * u) * ld + lane * 16); bv[u] = *(const u32x4*)(src + (size_t)(r0 + 8 * u) * ld + lane * 16 + 8); }
#pragma unroll
        for (int u = 0; u < 4; ++u) {
            const int rr = r0 + 8 * u;
            float f[16]; unpack8(av[u], f); unpack8(bv[u], f + 8);
            float am = 0.f;
#pragma unroll
            for (int j = 0; j < 16; ++j) am = fmaxf(am, fabsf(f[j]));
            am = wave_max(am);
            *(u32x4*)(dst + (size_t)rr * 1024 + lane * 16) = q16(f, am > 0.f ? 127.0f / am : 0.f);
            if (lane == 0) sal[rr] = am * (1.0f / 127.0f);
        }
    }
}
__device__ __forceinline__ void quant_rows_x(const float* x, unsigned char* xq, ldsp lds, int lane, int wave) {
    LAS float* sxl = (LAS float*)(lds + L_SXL); LAS float* rsl = (LAS float*)(lds + LDS_RSL);
    TILE_ROWS4(r0) {
        float4 xv[4][4];
#pragma unroll
        for (int u = 0; u < 4; ++u)
#pragma unroll
            for (int j = 0; j < 4; ++j) xv[u][j] = ((const float4*)(x + (size_t)(r0 + 8 * u) * DM + lane * 16))[j];
#pragma unroll
        for (int u = 0; u < 4; ++u) {
            const int rr = r0 + 8 * u;
            float f[16];
#pragma unroll
            for (int j = 0; j < 4; ++j) { f[4 * j] = xv[u][j].x; f[4 * j + 1] = xv[u][j].y; f[4 * j + 2] = xv[u][j].z; f[4 * j + 3] = xv[u][j].w; }
            float am = 0.f, ss = 0.f;
#pragma unroll
            for (int j = 0; j < 16; ++j) { am = fmaxf(am, fabsf(f[j])); ss += f[j] * f[j]; }
            am = wave_max(am); ss = wave_sum(ss);
            *(u32x4*)(xq + (size_t)rr * 1024 + lane * 16) = q16(f, am > 0.f ? 127.0f / am : 0.f);
            if (lane == 0) { sxl[rr] = am * (1.0f / 127.0f); rsl[rr] = __builtin_amdgcn_rsqf(ss * (1.0f / DM) + RMS_EPS); }
        }
    }
}

__device__ __forceinline__ void attn_head(const bf16_t* __restrict__ Q, const bf16_t* __restrict__ Kh, const bf16_t* __restrict__ Vh, bf16_t* __restrict__ O, ldsp lds) {
    int tid = threadIdx.x;
    asm volatile("" : "+v"(tid));
    const int lane = tid & 63, wave = tid >> 6;
    const int wvu = __builtin_amdgcn_readfirstlane(wave);
    const int tg = wave & 3, mh = wave >> 2, fr = lane & 31, fh = lane >> 5;
    const int t = tg * 32 + fr;
    bf16x8 qf[16];
#pragma unroll
    for (int ks = 0; ks < 16; ++ks) qf[ks] = *(const bf16x8*)(Q + (size_t)t * ZC + ks * 16 + fh * 8);
    {
        const int crow = tid >> 3, lslot = (tid & 7) ^ ((crow >> 1) & 7);
        const bf16_t* Kg = Kh + (size_t)crow * 1024 + lslot * 8;
#pragma unroll
        for (int kt = 0; kt < 4; ++kt)
#pragma unroll
            for (int j = 0; j < 4; ++j)
                __builtin_amdgcn_global_load_lds((const unsigned*)(Kg + (size_t)(64 * j) * 1024 + kt * 64), (LAS unsigned*)(lds + kt * 32768 + j * 8192 + wvu * 1024), 16, 0, 0);
    }
    f32x16 S[4];
#pragma unroll
    for (int j = 0; j < 4; ++j)
#pragma unroll
        for (int r = 0; r < 16; ++r) S[j][r] = 0.f;
#pragma unroll
    for (int kt = 0; kt < 4; ++kt) {
        if (kt == 0) asm volatile("s_waitcnt vmcnt(12)" ::: "memory");
        else if (kt == 1) asm volatile("s_waitcnt vmcnt(8)" ::: "memory");
        else if (kt == 2) asm volatile("s_waitcnt vmcnt(4)" ::: "memory");
        else asm volatile("s_waitcnt vmcnt(0)" ::: "memory");
        __builtin_amdgcn_s_barrier();
        ldsp base = lds + kt * 32768;
#pragma unroll
        for (int kk = 0; kk < 4; ++kk) {
            bf16x8 a[4];
#pragma unroll
            for (int j = 0; j < 4; ++j) a[j] = *(LAS bf16x8*)(base + swz(mh * 128 + j * 32 + fr, kk * 2 + fh));
#pragma unroll
            for (int j = 0; j < 4; ++j) S[j] = __builtin_amdgcn_mfma_f32_32x32x16_bf16(a[j], qf[kt * 4 + kk], S[j], 0, 0, 0);
        }
    }
    float mx = -3.0e38f;
#pragma unroll
    for (int j = 0; j < 4; ++j)
#pragma unroll
        for (int r = 0; r < 16; ++r) { S[j][r] *= 0.0625f; mx = fmaxf(mx, S[j][r]); }
    mx = fmaxf(mx, __shfl_xor(mx, 32));
    float sm = 0.f;
#pragma unroll
    for (int j = 0; j < 4; ++j)
#pragma unroll
        for (int r = 0; r < 16; ++r) { S[j][r] = __expf(S[j][r] - mx); sm += S[j][r]; }
    sm += __shfl_xor(sm, 32);
    LAS float* EX = (LAS float*)(lds + 135168);
    if (fh == 0) { EX[(mh * 128 + t) * 2] = mx; EX[(mh * 128 + t) * 2 + 1] = sm; }
    __syncthreads();
    const float mo = EX[((mh ^ 1) * 128 + t) * 2], so = EX[((mh ^ 1) * 128 + t) * 2 + 1];
    const float gm = fmaxf(mx, mo);
    const float fme = __expf(mx - gm), fot = __expf(mo - gm);
    const float fac = fme * rcp_(sm * fme + so * fot);
    const int crow = tid >> 3, lslot = (tid & 7) ^ ((crow >> 1) & 7);
    const bf16_t* Vg = Vh + (size_t)crow * 1024 + lslot * 8;
#define ATT_ISSUE_V(ms_, slot_) _Pragma("unroll") for (int j = 0; j < 4; ++j) \
        __builtin_amdgcn_global_load_lds((const unsigned*)(Vg + (size_t)(64 * j) * 1024 + (ms_) * 64), (LAS unsigned*)(lds + (slot_) * 32768 + j * 8192 + wvu * 1024), 16, 0, 0)
    ATT_ISSUE_V(0, 0);
    ATT_ISSUE_V(1, 1);
    ldsp PX = lds + 65536;
#pragma unroll
    for (int j = 0; j < 4; ++j)
#pragma unroll
        for (int s2 = 0; s2 < 2; ++s2) {
            u32x4 w;
#pragma unroll
            for (int i = 0; i < 4; ++i) w[i] = pack2(S[j][8 * s2 + 2 * i] * fac, S[j][8 * s2 + 2 * i + 1] * fac);
            *(LAS u32x4*)(PX + ((((mh * 4 + j) * 2 + s2) * 4 + tg) * 64 + lane) * 16) = w;
        }
    f32x16 Oa[4];
#pragma unroll
    for (int i = 0; i < 4; ++i)
#pragma unroll
        for (int r = 0; r < 16; ++r) Oa[i][r] = 0.f;
#pragma unroll
    for (int ms = 0; ms < 4; ++ms) {
        if (ms < 3) asm volatile("s_waitcnt vmcnt(4)" ::: "memory"); else asm volatile("s_waitcnt vmcnt(0)" ::: "memory");
        asm volatile("s_waitcnt lgkmcnt(0)" ::: "memory");
        __builtin_amdgcn_s_barrier();
        ldsp base = lds + (ms & 1) * 32768;
#pragma unroll
        for (int kq = 0; kq < 4; ++kq) {
            const int src = (((ms >> 1) * 4 + (ms & 1) * 2 + (kq >> 1)) * 2 + (kq & 1)) * 4 + tg;
            const bf16x8 bfr = *(LAS bf16x8*)(PX + (src * 64 + lane) * 16);
#pragma unroll
            for (int i = 0; i < 4; ++i) {
                const int row = mh * 128 + i * 32 + fr;
                using u32x2 = __attribute__((ext_vector_type(2))) unsigned;
                const u32x2 lo = *(LAS u32x2*)(base + swz(row, 2 * kq) + 8 * fh), hi = *(LAS u32x2*)(base + swz(row, 2 * kq + 1) + 8 * fh);
                const u32x4 av = {lo[0], lo[1], hi[0], hi[1]};
                Oa[i] = __builtin_amdgcn_mfma_f32_32x32x16_bf16(__builtin_bit_cast(bf16x8, av), bfr, Oa[i], 0, 0, 0);
            }
        }
        if (ms < 2) {
            asm volatile("s_waitcnt lgkmcnt(0)" ::: "memory");
            __builtin_amdgcn_s_barrier();
            ATT_ISSUE_V(ms + 2, ms & 1);
        }
    }
#undef ATT_ISSUE_V
#pragma unroll
    for (int i = 0; i < 4; ++i)
#pragma unroll
        for (int g = 0; g < 4; ++g)
            st_bf4(O + (size_t)t * ZC + mh * 128 + i * 32 + 8 * g + 4 * fh, Oa[i][4 * g], Oa[i][4 * g + 1], Oa[i][4 * g + 2], Oa[i][4 * g + 3]);
}

__device__ __forceinline__ void attn_all(const bf16_t* __restrict__ Qz, const bf16_t* __restrict__ Kb, const bf16_t* __restrict__ Vb, bf16_t* __restrict__ Oz, ldsp lds) {
    int tid = threadIdx.x;
    asm volatile("" : "+v"(tid));
    const int lane = tid & 63, wave = tid >> 6;
    const int wvu = __builtin_amdgcn_readfirstlane(wave);
    const int c16 = lane & 15, q = lane >> 4, t = wave * 16 + c16;
    const int crow = tid >> 3, lslot = (tid & 7) ^ ((crow >> 1) & 7);
    auto issue = [&](int n) {
        const int h = n >> 3, idx = n & 3;
        const bf16_t* src = (((n >> 2) & 1) ? Vb : Kb) + (size_t)((h * 4 + idx) * 256 + crow) * 64 + lslot * 8;
#pragma unroll
        for (int j = 0; j < 4; ++j)
            __builtin_amdgcn_global_load_lds((const unsigned*)(src + (size_t)(64 * j) * 64), (LAS unsigned*)(lds + (n & 3) * 32768 + j * 8192 + wvu * 1024), 16, 0, 0);
    };
    issue(0); issue(1); issue(2);
    const int rb = c16 * 128, xs = (c16 >> 1) & 7;
#define ATT_TOP(n_) do { const int nn_ = (n_); \
        if (nn_ + 2 < 32) asm volatile("s_waitcnt vmcnt(8)" ::: "memory"); else if (nn_ + 1 < 32) asm volatile("s_waitcnt vmcnt(4)" ::: "memory"); else asm volatile("s_waitcnt vmcnt(0)" ::: "memory"); \
        asm volatile("s_waitcnt lgkmcnt(0)" ::: "memory"); \
        __builtin_amdgcn_s_barrier(); \
        if (nn_ + 3 < 32) issue(nn_ + 3); } while (0)
#pragma unroll 1
    for (int h = 0; h < 4; ++h) {
        int rbl = rb, xsl = xs, ql = q;
        asm volatile("" : "+v"(rbl), "+v"(xsl), "+v"(ql));
        f32x4 S[16];
#pragma unroll
        for (int jj = 0; jj < 16; ++jj) S[jj] = (f32x4){0.f, 0.f, 0.f, 0.f};
        bf16x8 qf[8];
#pragma unroll
        for (int ks = 0; ks < 8; ++ks) qf[ks] = *(const bf16x8*)(Qz + (size_t)t * ZC + h * 256 + ks * 32 + q * 8);
#pragma unroll
        for (int kt = 0; kt < 4; ++kt) {
            const int n = h * 8 + kt;
            ATT_TOP(n);
            ldsp base = lds + kt * 32768 + rbl;
            bf16x8 fa[8], fb[8];
#define ATT_RD_S(F, g_) do { ldsp pa_ = base + (((((g_) >> 1) * 4 + ql) ^ xsl) & 7) * 16 + ((g_) & 1) * 16384; \
                _Pragma("unroll") for (int u = 0; u < 8; ++u) F[u] = *(LAS bf16x8*)(pa_ + u * 2048); } while (0)
#define ATT_MM_S(F, g_) do { _Pragma("unroll") for (int u = 0; u < 8; ++u) \
                S[((g_) & 1) * 8 + u] = __builtin_amdgcn_mfma_f32_16x16x32_bf16(F[u], qf[kt * 2 + ((g_) >> 1)], S[((g_) & 1) * 8 + u], 0, 0, 0); } while (0)
            ATT_RD_S(fa, 0);
            ATT_RD_S(fb, 1); ATT_MM_S(fa, 0);
            __builtin_amdgcn_sched_group_barrier(0x008, 1, 0); __builtin_amdgcn_sched_group_barrier(0x100, 8, 0); __builtin_amdgcn_sched_group_barrier(0x008, 7, 0);
            ATT_RD_S(fa, 2); ATT_MM_S(fb, 1);
            __builtin_amdgcn_sched_group_barrier(0x008, 1, 0); __builtin_amdgcn_sched_group_barrier(0x100, 8, 0); __builtin_amdgcn_sched_group_barrier(0x008, 7, 0);
            ATT_RD_S(fb, 3); ATT_MM_S(fa, 2);
            __builtin_amdgcn_sched_group_barrier(0x008, 1, 0); __builtin_amdgcn_sched_group_barrier(0x100, 8, 0); __builtin_amdgcn_sched_group_barrier(0x008, 7, 0);
            ATT_MM_S(fb, 3);
            __builtin_amdgcn_sched_group_barrier(0x008, 8, 0);
#undef ATT_RD_S
#undef ATT_MM_S
        }
        float mx = -3.0e38f;
#pragma unroll
        for (int jj = 0; jj < 16; ++jj)
#pragma unroll
            for (int r = 0; r < 4; ++r) { S[jj][r] *= 0.0625f; mx = fmaxf(mx, S[jj][r]); }
        mx = fmaxf(mx, __shfl_xor(mx, 16)); mx = fmaxf(mx, __shfl_xor(mx, 32));
        float sm = 0.f;
#pragma unroll
        for (int jj = 0; jj < 16; ++jj)
#pragma unroll
            for (int r = 0; r < 4; ++r) { S[jj][r] = __expf(S[jj][r] - mx); sm += S[jj][r]; }
        sm += __shfl_xor(sm, 16); sm += __shfl_xor(sm, 32);
        const float inv = rcp_(sm);
        u32x4 pk[8];
#pragma unroll
        for (int kk2 = 0; kk2 < 8; ++kk2) {
            pk[kk2][0] = pack2(S[2 * kk2][0] * inv, S[2 * kk2][1] * inv); pk[kk2][1] = pack2(S[2 * kk2][2] * inv, S[2 * kk2][3] * inv);
            pk[kk2][2] = pack2(S[2 * kk2 + 1][0] * inv, S[2 * kk2 + 1][1] * inv); pk[kk2][3] = pack2(S[2 * kk2 + 1][2] * inv, S[2 * kk2 + 1][3] * inv);
        }
        f32x4 Oa[16];
#pragma unroll
        for (int ii = 0; ii < 16; ++ii) Oa[ii] = (f32x4){0.f, 0.f, 0.f, 0.f};
#pragma unroll
        for (int vs = 0; vs < 4; ++vs) {
            const int n = h * 8 + 4 + vs;
            ATT_TOP(n);
            ldsp base = lds + vs * 32768 + rbl + 8 * (ql & 1);
            using u32x2 = __attribute__((ext_vector_type(2))) unsigned;
            u32x4 va[8], vb_[8];
#define ATT_RD_V(F, g_) do { ldsp plo_ = base + ((((4 * ((g_) >> 1) + (ql >> 1)) ^ xsl) & 7) << 4) + ((g_) & 1) * 16384, phi_ = base + ((((4 * ((g_) >> 1) + 2 + (ql >> 1)) ^ xsl) & 7) << 4) + ((g_) & 1) * 16384; \
                _Pragma("unroll") for (int u = 0; u < 8; ++u) { const u32x2 lo_ = *(LAS u32x2*)(plo_ + u * 2048), hi_ = *(LAS u32x2*)(phi_ + u * 2048); F[u] = (u32x4){lo_[0], lo_[1], hi_[0], hi_[1]}; } } while (0)
#define ATT_MM_V(F, g_) do { const bf16x8 bfr_ = __builtin_bit_cast(bf16x8, pk[vs * 2 + ((g_) >> 1)]); _Pragma("unroll") for (int u = 0; u < 8; ++u) \
                Oa[((g_) & 1) * 8 + u] = __builtin_amdgcn_mfma_f32_16x16x32_bf16(__builtin_bit_cast(bf16x8, F[u]), bfr_, Oa[((g_) & 1) * 8 + u], 0, 0, 0); } while (0)
            ATT_RD_V(va, 0);
            ATT_RD_V(vb_, 1); ATT_MM_V(va, 0);
            __builtin_amdgcn_sched_group_barrier(0x008, 1, 0); __builtin_amdgcn_sched_group_barrier(0x100, 16, 0); __builtin_amdgcn_sched_group_barrier(0x008, 7, 0);
            ATT_RD_V(va, 2); ATT_MM_V(vb_, 1);
            __builtin_amdgcn_sched_group_barrier(0x008, 1, 0); __builtin_amdgcn_sched_group_barrier(0x100, 16, 0); __builtin_amdgcn_sched_group_barrier(0x008, 7, 0);
            ATT_RD_V(vb_, 3); ATT_MM_V(va, 2);
            __builtin_amdgcn_sched_group_barrier(0x008, 1, 0); __builtin_amdgcn_sched_group_barrier(0x100, 16, 0); __builtin_amdgcn_sched_group_barrier(0x008, 7, 0);
            ATT_MM_V(vb_, 3);
            __builtin_amdgcn_sched_group_barrier(0x008, 8, 0);
#undef ATT_RD_V
#undef ATT_MM_V
        }
#pragma unroll
        for (int ii = 0; ii < 16; ++ii) st_bf4(Oz + (size_t)t * ZC + h * 256 + ii * 16 + 4 * q, Oa[ii][0], Oa[ii][1], Oa[ii][2], Oa[ii][3]);
    }
#undef ATT_TOP
}

__device__ void phase_e(const Params& p, int l, ldsp lds, const XcdBarrier& bar, int erep) {
    const bool xwr = (PROBE & 524288) ? (erep == 1) : true;
    const int bid = bid_opaque(), G = gridDim.x;
    float* x = p.out;
    LAS float* rsl = (LAS float*)(lds + LDS_RSL);
    LAS float* ssq = (LAS float*)(lds + L_SSQ);
    enum { OP_GLU = 0, OP_XADD, OP_RS, OP_SOFTMAX, OP_STORE, OP_Z };
    const int nsteps = (l + 1 < NL) ? 25 : 20;
#pragma unroll 1
    for (int rt = bid; rt < 256; rt += G) {
        const int row0 = rt * 128, b = rt >> 6;
#pragma unroll 1
        for (int stepi = 0, pdup = 0; stepi < nsteps; ) {
            const int step = stepi;
            if ((PROBE & 131072) && step >= 5 && step <= 12 && pdup == 0) pdup = 1; else if ((PROBE & 262144) && step == 0 && pdup == 0) pdup = 1; else { pdup = 0; ++stepi; }
            int tid = threadIdx.x;
            asm volatile("" : "+v"(tid));
            if (step >= 6 && step < 13) continue;
            const int lane = tid & 63, wave = __builtin_amdgcn_readfirstlane(tid >> 6);
            unsigned char* wsl = ptr_opaque(p.ws);
            unsigned char* W = wsl + WS_WT + (size_t)l * WT_LAYER;
            const unsigned char* W8 = wsl + WS_W8 + (size_t)l * W8_LAYER;
            unsigned char* xqr = wsl + WS_XQ + (size_t)row0 * 1024;
            const float* SW = (const float*)(W + WO_SW);
            LAS float* sxl = (LAS float*)(lds + L_SXL);
            bf16_t* zb = (bf16_t*)(wsl + WS_Z);
            bf16_t* ymix = (bf16_t*)(wsl + WS_YMIX);
            bf16_t* zr = zb + (size_t)row0 * ZC;
            unsigned char* scr = wsl + WS_SCR + (size_t)bid * SCR_BLK;
            bf16_t* Psc = (bf16_t*)(scr);
            unsigned* SEL = (unsigned*)(scr + 65536);
            unsigned char* aq = scr + 65536;
            if (step == 19) {
#pragma unroll 1
                for (int e7rep = 0; e7rep < ((PROBE & 65536) ? 2 : 1); ++e7rep)
                if (ESUB & 1) {
                    if (e7rep) block_gsync();
                    LAS float* SC = (LAS float*)lds;
                    LAS int* PL = (LAS int*)(lds + 66048);
                    int* FIN = (int*)(scr + 196608);
                    const bf16_t* keys = (const bf16_t*)(W + WO_KEYS);
                    constexpr int E7_RING = 66560, E7_STAGE = 32768;
                    const int crow_ = tid >> 3, lslot_ = (tid & 7) ^ ((crow_ >> 1) & 7);
                    const int wvu_ = __builtin_amdgcn_readfirstlane(tid >> 6);
                    auto e7_issue = [&](int hc) {
                        const bf16_t* Ag = zr + hc * 128 + (size_t)crow_ * ZC + lslot_ * 8;
                        const bf16_t* Bg = keys + (size_t)hc * 128 * 128 + (size_t)crow_ * 128 + lslot_ * 8;
#pragma unroll
                        for (int kt = 0; kt < 2; ++kt)
#pragma unroll
                            for (int j = 0; j < 2; ++j) {
                                __builtin_amdgcn_global_load_lds((const unsigned*)(Ag + (size_t)(64 * j) * ZC + kt * 64), (LAS unsigned*)(lds + E7_RING + kt * E7_STAGE + j * 8192 + wvu_ * 1024), 16, 0, 0);
                                __builtin_amdgcn_global_load_lds((const unsigned*)(Bg + (size_t)(64 * j) * 128 + kt * 64), (LAS unsigned*)(lds + E7_RING + kt * E7_STAGE + 16384 + j * 8192 + wvu_ * 1024), 16, 0, 0);
                            }
                    };
                    e7_issue(0);
#pragma unroll 1
                    for (int hc = 0; hc < 16; ++hc) {
                        asm volatile("s_waitcnt vmcnt(0)" ::: "memory");
                        __builtin_amdgcn_s_barrier();
                        {
                            const int wm = wave >> 2, wn = wave & 3, fr = lane & 31, fh = lane >> 5;
                            f32x16 acc0 = zero16(), acc1 = zero16();
#pragma unroll
                            for (int kt = 0; kt < 2; ++kt) {
                                ldsp base = lds + E7_RING + kt * E7_STAGE;
                                bf16x8 a0[4], a1[4], b0[4];
#pragma unroll
                                for (int kk = 0; kk < 4; ++kk) {
                                    a0[kk] = *(LAS bf16x8*)(base + swz(wm * 64 + fr, kk * 2 + fh));
                                    a1[kk] = *(LAS bf16x8*)(base + swz(wm * 64 + 32 + fr, kk * 2 + fh));
                                    b0[kk] = *(LAS bf16x8*)(base + 16384 + swz(wn * 32 + fr, kk * 2 + fh));
                                }
                                __builtin_amdgcn_sched_group_barrier(0x100, 12, 0);
#pragma unroll
                                for (int kk = 0; kk < 4; ++kk) {
                                    acc0 = __builtin_amdgcn_mfma_f32_32x32x16_bf16(a0[kk], b0[kk], acc0, 0, 0, 0);
                                    acc1 = __builtin_amdgcn_mfma_f32_32x32x16_bf16(a1[kk], b0[kk], acc1, 0, 0, 0);
                                }
                                __builtin_amdgcn_sched_group_barrier(0x008, 8, 0);
                            }
                            LAS float* tp0 = SC + (wm * 64 + 4 * fh) * 129 + wn * 32 + fr;
#pragma unroll
                            for (int r = 0; r < 16; ++r) { tp0[((r & 3) + 8 * (r >> 2)) * 129] = acc0[r]; tp0[(32 + (r & 3) + 8 * (r >> 2)) * 129] = acc1[r]; }
                        }
                        asm volatile("s_waitcnt lgkmcnt(0)" ::: "memory");
                        __builtin_amdgcn_s_barrier();
                        if (hc + 1 < 16) e7_issue(hc + 1);
                        {
                            const int tq = lane >> 2, kq = lane & 3, t = wave * 16 + tq, rot = (kq >> 1) * 16;
                            int a[16], bq[16];
#pragma unroll
                            for (int i = 0; i < 16; ++i) {
                                const int c0 = (i + rot) & 31, c1 = (16 + i + rot) & 31;
                                a[i] = f2key(SC[t * 129 + kq * 32 + c0], kq * 32 + c0, 127);
                                bq[i] = f2key(SC[t * 129 + kq * 32 + c1], kq * 32 + c1, 127);
                            }
                            sort16_desc(a); sort16_desc(bq); merge16_desc(a, bq);
#pragma unroll
                            for (int i = 0; i < 16; ++i) bq[i] = dppi<0xB1>(a[i]);
                            merge16_desc(a, bq);
#pragma unroll
                            for (int i = 0; i < 16; ++i) bq[i] = dppi<0x4E>(a[i]);
                            merge16_desc(a, bq);
#pragma unroll
                            for (int j = 0; j < 4; ++j) {
                                const int v = kq == 0 ? a[j] : kq == 1 ? a[4 + j] : kq == 2 ? a[8 + j] : a[12 + j];
                                FIN[(hc * 16 + kq * 4 + j) * 128 + t] = v;
                            }
                        }
                        asm volatile("s_waitcnt lgkmcnt(0)" ::: "memory");
                    }
                    block_gsync();
                    {
                        LAS int* LK = (LAS int*)(lds + wave * 8192);
                        const int hd = wave;
#pragma unroll 1
                        for (int th = 0; th < 2; ++th) {
                            const int t = th * 64 + lane;
                            float f1[16], f2[16];
#pragma unroll
                            for (int i = 0; i < 16; ++i) {
                                const int u1 = key2u(FIN[((hd * 2) * 16 + i) * 128 + t]), u2 = key2u(FIN[((hd * 2 + 1) * 16 + i) * 128 + t]);
                                f1[i] = __int_as_float(u1); f2[i] = __int_as_float(u2);
                                LK[i * 64 + lane] = u1 & 127; LK[(16 + i) * 64 + lane] = u2 & 127;
                            }
                            int g0[16], g1[16], g2[16], g3[16];
                            {
                                int n = 0;
#pragma unroll
                                for (int a = 0; a < 16; ++a)
#pragma unroll
                                    for (int b2 = 0; b2 < 16; ++b2)
                                        if ((a + 1) * (b2 + 1) <= 16) {
                                            const int k = f2key(f1[a] + f2[b2], a * 16 + b2, 255);
                                            if (n < 16) g0[n] = k; else if (n < 32) g1[n - 16] = k; else if (n < 48) g2[n - 32] = k; else g3[n - 48] = k;
                                            ++n;
                                        }
#pragma unroll
                                for (int i = 2; i < 16; ++i) g3[i] = (int)0x80000000;
                            }
                            sort16_desc(g0); sort16_desc(g1); sort16_desc(g2); sort16_desc(g3);
                            merge16_desc(g0, g1); merge16_desc(g2, g3); merge16_desc(g0, g2);
                            asm volatile("s_waitcnt lgkmcnt(0)" ::: "memory");
                            float val[16]; float sm = 0.f;
                            const float mx = __int_as_float(key2u(g0[0]));
#pragma unroll
                            for (int i = 0; i < 16; ++i) { val[i] = __expf(__int_as_float(key2u(g0[i])) - mx); sm += val[i]; }
                            const float inv = rcp_(sm);
#pragma unroll
                            for (int i = 0; i < 16; ++i) {
                                const int code = key2u(g0[i]) & 255;
                                const int eid = LK[(code >> 4) * 64 + lane] * 128 + LK[(16 + (code & 15)) * 64 + lane];
                                const float su_e = ((const float*)(W + WO_SU))[eid], sv_e = ((const float*)(W + WO_SV))[eid];
                                uint2 o; o.x = (unsigned)eid | ((unsigned)f2bf(su_e) << 16); o.y = __float_as_uint(val[i] * inv * sv_e);
                                *(uint2*)(SEL + ((size_t)(t * 8 + hd) * 16 + i) * 2) = o;
                            }
                            asm volatile("s_waitcnt lgkmcnt(0)" ::: "memory");
                        }
                    }
                }
                block_gsync();
                if (ESUB & 2) {
                    const unsigned char* ub8 = wsl + WS_UB + (size_t)l * 16384 * 1024;
                    const unsigned char* vb8 = wsl + WS_VB + (size_t)l * 16384 * 1024;
                    float* rsg = (float*)(wsl + WS_RS); float* sxg = (float*)(wsl + WS_SX);
                    const float* gfin = p.in[I_NFIN];
                    unsigned* SP = (unsigned*)(scr + 196608);
                    float* COEF = (float*)(scr + 196608 + 65536);
                    LAS unsigned* hist = (LAS unsigned*)(lds + 133120);
                    const int q = lane >> 4, n = lane & 15;
#pragma unroll 1
                    for (int srep = 0; srep < ((PROBE & 2097152) ? 2 : 1); ++srep) {
                    if (srep) block_gsync();
                    if (tid < 128) hist[tid] = 0u;
#pragma unroll 1
                    for (int ch0 = tid; ch0 < 8192; ch0 += 8 * NTHREADS) {
                        u32x4 cv[8];
#pragma unroll
                        for (int u = 0; u < 8; ++u) { const int ch = ch0 + u * NTHREADS; cv[u] = *(const u32x4*)(xqr + (size_t)(ch >> 6) * 1024 + (ch & 63) * 16); }
#pragma unroll
                        for (int u = 0; u < 8; ++u) { const int ch = ch0 + u * NTHREADS; *(LAS u32x4*)(lds + (ch >> 6) * 1040 + (ch & 63) * 16) = cv[u]; }
                    }
                    __syncthreads();
                    unsigned keys[32];
#pragma unroll
                    for (int j = 0; j < 32; ++j) {
                        const unsigned i = (unsigned)tid + 512u * j;
                        const unsigned eid = SEL[(size_t)i * 2] & 0xffffu;
                        keys[j] = (eid << 14) | i;
                        __hip_atomic_fetch_add(&hist[eid >> 7], 1u, __ATOMIC_RELAXED, __HIP_MEMORY_SCOPE_WORKGROUP);
                    }
                    __syncthreads();
                    if (wave == 0) {
                        const unsigned c0 = hist[2 * lane], c1 = hist[2 * lane + 1];
                        unsigned inc = c0 + c1;
#pragma unroll
                        for (int o = 1; o < 64; o <<= 1) { const unsigned t_ = (unsigned)__shfl_up((int)inc, o); if (lane >= o) inc += t_; }
                        const unsigned exc = inc - (c0 + c1);
                        hist[2 * lane] = exc; hist[2 * lane + 1] = exc + c0;
                    }
                    __syncthreads();
#pragma unroll
                    for (int j = 0; j < 32; ++j) {
                        const unsigned pos = __hip_atomic_fetch_add(&hist[keys[j] >> 21], 1u, __ATOMIC_RELAXED, __HIP_MEMORY_SCOPE_WORKGROUP);
                        SP[pos] = keys[j];
                    }
                    }
                    block_gsync();
                    if (G == 256) xcd_barrier(bar);
                    {
                        unsigned k4n = SP[wave * 64 + lane];
#pragma unroll 1
                        for (int it = 0; it < 32; ++it) {
                            const unsigned k4 = k4n;
                            if (it + 1 < 32) k4n = SP[(wave + 8 * (it + 1)) * 64 + lane];
                            const uint2 se = *(const uint2*)(SEL + ((size_t)((k4 >> 7) & 127u) * 128 + (k4 & 127u)) * 2);
                            u32x4 ur[4][4];
                            unsigned keyr[4];
#pragma unroll
                            for (int t = 0; t < 4; ++t) {
                                keyr[t] = (unsigned)__shfl((int)k4, (lane & 48) + t);
                                const unsigned char* up = ub8 + (size_t)(keyr[t] >> 14) * 1024 + n * 16;
#pragma unroll
                                for (int c = 0; c < 4; ++c) ur[t][c] = *(const u32x4*)(up + c * 256);
                            }
                            int dvec = 0;
#pragma unroll
                            for (int t = 0; t < 16; ++t) {
                                const int tok = (int)((keyr[t & 3] >> 7) & 127u);
                                ldsp xr = lds + tok * 1040 + n * 16;
                                u32x4 xv[4];
#pragma unroll
                                for (int c = 0; c < 4; ++c) xv[c] = *(LAS u32x4*)(xr + c * 256);
                                __builtin_amdgcn_sched_group_barrier(0x100, 4, 0);
                                int sc4[4] = {0, 0, 0, 0};
#pragma unroll
                                for (int e = 0; e < 4; ++e)
#pragma unroll
                                    for (int c = 0; c < 4; ++c) sc4[c] = __builtin_amdgcn_sdot4((int)ur[t & 3][c][e], (int)xv[c][e], sc4[c], false);
                                int sacc = (sc4[0] + sc4[1]) + (sc4[2] + sc4[3]);
                                if (t + 4 < 16) {
                                    keyr[t & 3] = (unsigned)__shfl((int)k4, (lane & 48) + t + 4);
                                    const unsigned char* up = ub8 + (size_t)(keyr[t & 3] >> 14) * 1024 + n * 16;
#pragma unroll
                                    for (int c = 0; c < 4; ++c) ur[t & 3][c] = *(const u32x4*)(up + c * 256);
                                }
                                sacc = row16_sum_i(sacc);
                                if (n == t) dvec = sacc;
                            }
                            {
                                const int tok = (int)((k4 >> 7) & 127u), slot = (int)(k4 & 127u);
                                COEF[tok * 128 + slot] = __uint_as_float(se.y) * gelu_((float)dvec * bfhi(se.x) * sxl[tok] * rsl[tok]);
                            }
                        }
                    }
                    block_gsync();
                    {
                        LAS float* SSQ2 = (LAS float*)(lds + 133632); LAS float* AMX = (LAS float*)(lds + 134144);
                        LAS float* SCL = (LAS float*)(lds + 134656); LAS int* CSI = (LAS int*)(lds + 135168);
                        using u2 = __attribute__((ext_vector_type(2))) unsigned;
                        typedef short s16x2 __attribute__((ext_vector_type(2)));
#pragma unroll 1
                        for (int i4 = 0; i4 < 16; i4 += 4) {
                          float2 c01v[4]; uint4 sev[4];
#pragma unroll
                          for (int u = 0; u < 4; ++u) { c01v[u] = *(const float2*)(COEF + (wave * 16 + i4 + u) * 128 + 2 * lane); sev[u] = *(const uint4*)(SEL + ((size_t)(wave * 16 + i4 + u) * 128 + 2 * lane) * 2); }
#pragma unroll
                          for (int u = 0; u < 4; ++u) {
                            const int rr = wave * 16 + i4 + u;
                            const float2 c01 = c01v[u];
                            const uint4 se = sev[u];
                            const float cmax = wave_max(fmaxf(fabsf(c01.x), fabsf(c01.y)));
                            const float sc = cmax > 0.f ? 127.0f / cmax : 0.f;
                            const int q0 = (int)rintf(c01.x * sc), q1 = (int)rintf(c01.y * sc);
                            const unsigned cw = ((unsigned)q0 & 255u) | (((unsigned)q1 & 255u) << 8);
                            const unsigned ew = (se.x & 0xffffu) | (se.z << 16);
                            const unsigned cwn = (unsigned)dppi<0xB1>((int)cw), ewn = (unsigned)dppi<0xB1>((int)ew);
                            if ((lane & 1) == 0) { u32x4 e; e[0] = ew; e[1] = ewn; e[2] = cw | (cwn << 16); e[3] = 0u; *(LAS u32x4*)(lds + rr * 528 + (lane >> 1) * 16) = e; }
                            if (lane == 0) SCL[rr] = cmax * (1.0f / 127.0f);
                          }
                        }
                        __syncthreads();
                        const int tl = lane >> 3, cc = lane & 7;
#define P2_LOAD(V, C, base) _Pragma("unroll") for (int u = 0; u < 2; ++u) { u32x4 e = *(LAS u32x4*)(pr + ((base) + u) * 16); C[u] = e[2]; if ((PROBE & 8192) && prep == 0) { e[0] &= 0x007f007fu; e[1] &= 0x007f007fu; } \
                                V[4 * u] = *(const u32x4*)(vk + (((e[0] & 0xffffu) << 7) | ccoff)); V[4 * u + 1] = *(const u32x4*)(vk + (((e[0] >> 16) << 7) | ccoff)); \
                                V[4 * u + 2] = *(const u32x4*)(vk + (((e[1] & 0xffffu) << 7) | ccoff)); V[4 * u + 3] = *(const u32x4*)(vk + (((e[1] >> 16) << 7) | ccoff)); }
#define P2_COMP(V, C) _Pragma("unroll") for (int u = 0; u < 2; ++u) { const int c4 = (int)C[u]; \
                                _Pragma("unroll") for (int i = 0; i < 4; ++i) { const unsigned wa = V[4 * u][i], wb = V[4 * u + 1][i], wc = V[4 * u + 2][i], wd = V[4 * u + 3][i]; \
                                    const unsigned pp = __builtin_amdgcn_perm(wb, wa, 0x05010400u), qq = __builtin_amdgcn_perm(wb, wa, 0x07030602u); \
                                    const unsigned rr_ = __builtin_amdgcn_perm(wd, wc, 0x05010400u), ss = __builtin_amdgcn_perm(wd, wc, 0x07030602u); \
                                    acc[4 * i]     = __builtin_amdgcn_sdot4((int)__builtin_amdgcn_perm(rr_, pp, 0x05040100u), c4, acc[4 * i], false); \
                                    acc[4 * i + 1] = __builtin_amdgcn_sdot4((int)__builtin_amdgcn_perm(rr_, pp, 0x07060302u), c4, acc[4 * i + 1], false); \
                                    acc[4 * i + 2] = __builtin_amdgcn_sdot4((int)__builtin_amdgcn_perm(ss, qq, 0x05040100u), c4, acc[4 * i + 2], false); \
                                    acc[4 * i + 3] = __builtin_amdgcn_sdot4((int)__builtin_amdgcn_perm(ss, qq, 0x07060302u), c4, acc[4 * i + 3], false); } }
#pragma unroll 1
                        for (int prep = 0; prep < ((PROBE & 4096) ? 2 : 1); ++prep)
#pragma unroll 1
                        for (int k = 0; k < 8; ++k) {
                            const unsigned char* vk = vb8 + (size_t)k * (16384 * 128);
                            const unsigned ccoff = (unsigned)cc * 16u;
#pragma unroll 1
                            for (int ps = 0; ps < 2; ++ps) {
                                const int rr = wave * 16 + ps * 8 + tl;
                                ldsp pr = lds + rr * 528;
                                int acc[16];
#pragma unroll
                                for (int i = 0; i < 16; ++i) acc[i] = 0;
                                u32x4 va[8], vb_[8]; unsigned ca[2], cb[2];
                                P2_LOAD(va, ca, 0)
#pragma unroll 1
                                for (int j = 0; j < 32; j += 4) {
                                    P2_LOAD(vb_, cb, j + 2)
                                    P2_COMP(va, ca)
                                    if (j + 4 < 32) { P2_LOAD(va, ca, j + 4) }
                                    P2_COMP(vb_, cb)
                                }
                                const float scl = SCL[rr]; const int off = 0;
                                float4* xp = (float4*)(x + (size_t)(row0 + rr) * DM + k * 128 + cc * 16);
                                float ss = 0.f, am = 0.f;
#pragma unroll
                                for (int i = 0; i < 4; ++i) {
                                    float4 h4 = xp[i];
                                    h4.x += (float)(acc[4 * i] - off) * scl; h4.y += (float)(acc[4 * i + 1] - off) * scl; h4.z += (float)(acc[4 * i + 2] - off) * scl; h4.w += (float)(acc[4 * i + 3] - off) * scl;
                                    if ((!(PROBE & 4096) || prep == 1) && xwr) xp[i] = h4;
                                    ss += h4.x * h4.x + h4.y * h4.y + h4.z * h4.z + h4.w * h4.w;
                                    am = fmaxf(am, fmaxf(fmaxf(fabsf(h4.x), fabsf(h4.y)), fmaxf(fabsf(h4.z), fabsf(h4.w))));
                                }
                                ss = grp8_sum(ss);
                                am = fmaxf(am, dppf<0xB1>(am)); am = fmaxf(am, dppf<0x4E>(am)); am = fmaxf(am, dppf<0x141>(am));
                                if (cc == 0 && (!(PROBE & 4096) || prep == 1)) { SSQ2[rr] = (k == 0 ? 0.f : SSQ2[rr]) + ss; AMX[rr] = fmaxf(k == 0 ? 0.f : AMX[rr], am); }
                            }
                        }
                        asm volatile("s_waitcnt vmcnt(0) lgkmcnt(0)" ::: "memory");
#pragma unroll 1
                        for (int i4 = 0; i4 < 16; i4 += 4) {
                          float4 xv4[4][4];
#pragma unroll
                          for (int u = 0; u < 4; ++u)
#pragma unroll
                              for (int j = 0; j < 4; ++j) xv4[u][j] = ((const float4*)(x + (size_t)(row0 + wave * 16 + i4 + u) * DM + lane * 16))[j];
#pragma unroll
                          for (int u = 0; u < 4; ++u) {
                            const int rr = wave * 16 + i4 + u, row = row0 + rr;
                            const float rn = __builtin_amdgcn_rsqf(SSQ2[rr] * (1.0f / DM) + RMS_EPS);
                            float hx[16];
#pragma unroll
                            for (int j = 0; j < 4; ++j) { hx[4 * j] = xv4[u][j].x; hx[4 * j + 1] = xv4[u][j].y; hx[4 * j + 2] = xv4[u][j].z; hx[4 * j + 3] = xv4[u][j].w; }
                            if (l == NL - 1) {
                                float4* xw = (float4*)(x + (size_t)row * DM + lane * 16);
                                const float4* gp = (const float4*)(gfin + lane * 16);
#pragma unroll
                                for (int j = 0; j < 4; ++j) { const float4 g4 = gp[j]; if (xwr) xw[j] = make_float4(hx[4 * j] * rn * g4.x, hx[4 * j + 1] * rn * g4.y, hx[4 * j + 2] * rn * g4.z, hx[4 * j + 3] * rn * g4.w); }
                            } else {
                                const float am2 = AMX[rr];
                                *(u32x4*)(xqr + (size_t)rr * 1024 + lane * 16) = q16(hx, am2 > 0.f ? 127.0f / am2 : 0.f);
                                if (lane == 0) { rsg[row] = rn; sxg[row] = am2 * (1.0f / 127.0f); rsl[rr] = rn; sxl[rr] = am2 * (1.0f / 127.0f); }
                            }
                          }
                        }
                    }
                }
                block_gsync();
                continue;
            }
            const unsigned char* A; const unsigned char* Bt; int lda, ldb, KB, op, sub, kst = 64; bool wide = true, i8 = true; const float* sw = SW;
            if (step < 1)       { sub = 0;         op = OP_GLU;  i8 = false; A = (const unsigned char*)(ymix + (size_t)row0 * DM + 512); lda = 2048; Bt = W + WO_GLU; ldb = 1024; KB = 1024; }
            else if (step < 3)  { sub = step - 1;  op = OP_XADD; i8 = false; A = (const unsigned char*)(ymix + (size_t)row0 * DM); lda = 2048; Bt = W + WO_WOUT + (size_t)sub * 512 * 2048; ldb = 2048; KB = 2048; }
            else if (step < 5)  { sub = step - 3;  op = OP_RS;   A = xqr; lda = 1024; Bt = W8 + W8_WQ + (size_t)sub * 524288; ldb = 64; kst = 32768; KB = 1024; sw = SW + SW_WQ; }
            else if (step < 13) {
                sub = (step - 5) >> 1; wide = false; i8 = false;
                if (((step - 5) & 1) == 0) { op = OP_SOFTMAX; A = (const unsigned char*)(zr + sub * 256); lda = ZC * 2; Bt = wsl + WS_KMEM + ((size_t)l * 1024 * 1024 + (size_t)(b * 256) * 1024 + sub * 256) * 2; ldb = 2048; KB = 512; }
                else { op = OP_STORE; A = (const unsigned char*)Psc; lda = 512; Bt = wsl + WS_VMEMT + ((size_t)l * 1024 * 1024 + (size_t)(sub * 256) * 1024 + b * 256) * 2; ldb = 2048; KB = 512; }
            }
            else if (step < 15) { sub = step - 13; op = OP_XADD; A = aq; lda = 1024; Bt = W8 + W8_WO + (size_t)sub * 524288; ldb = 64; kst = 32768; KB = 1024; sw = SW + SW_WO; }
            else if (step < 19) { sub = step - 15; op = OP_RS;   A = xqr; lda = 1024; Bt = W8 + W8_WPQ + (size_t)sub * 524288; ldb = 64; kst = 32768; KB = 1024; sw = SW + SW_WPQ; }
            else                { sub = step - 20; op = OP_Z;    A = xqr; lda = 1024; Bt = wsl + WS_W8 + (size_t)(l + 1) * W8_LAYER + W8_WIN + (size_t)sub * 524288; ldb = 64; kst = 32768; KB = 1024;
                                  sw = (const float*)(wsl + WS_WT + (size_t)(l + 1) * WT_LAYER + WO_SW) + SW_WIN; }
            if (step == 0) { if (tid < 128) ssq[tid] = 0.f; __syncthreads(); }
            if (step == 13) { quant_rows_bf16(zr + 1024, ZC, aq, lds, lane, wave); block_gsync(); }
            if (wide && i8) {
                i32x16 acc5[2][4];
#pragma unroll 1
                for (int prep_ = 0; prep_ < ((PROBE & 16384) ? 2 : 1); ++prep_)
                gemm512_acc<true>(A, lda, Bt, ldb, kst, KB, lds, acc5);
#pragma unroll 1
                for (int h = 0; h < 2; ++h) {
                    gemm512_store_half(acc5, h, lds);
                    const int col0 = sub * 512 + h * 256;
                    if (op == OP_XADD) {
                        xadd_rowpass_i(lds, x, sw, row0, col0, lane, wave, xwr);
                    } else if (op == OP_RS) {
                        const float4 w4 = *(const float4*)(sw + col0 + lane * 4);
                        TILE_ROWS4(r0) {
                            f32x4 v[4]; float r[4];
#pragma unroll
                            for (int u = 0; u < 4; ++u) { v[u] = tile4i(lds, r0 + 8 * u, lane); r[u] = rsl[r0 + 8 * u] * sxl[r0 + 8 * u]; }
                            __builtin_amdgcn_sched_group_barrier(0x100, 12, 0);
#pragma unroll
                            for (int u = 0; u < 4; ++u) st_bf4(zr + (size_t)(r0 + 8 * u) * ZC + col0 + lane * 4, v[u][0] * r[u] * w4.x, v[u][1] * r[u] * w4.y, v[u][2] * r[u] * w4.z, v[u][3] * r[u] * w4.w);
                        }
                    } else {
                        z_rowpass(lds, zb, [&](int rr) { return rsl[rr] * sxl[rr]; }, sw, row0, col0, ZN1, lane, wave);
                    }
                    __syncthreads();
                }
            } else if (wide) {
                f32x16 acc5[2][4];
                gemm512_acc<false>(A, lda, Bt, ldb, kst, KB, lds, acc5);
#pragma unroll 1
                for (int h = 0; h < 2; ++h) {
                    gemm512_store_half(acc5, h, lds);
                    const int col0 = sub * 512 + h * 256;
                    if (op == OP_GLU) {
                        const float4 bias = *(const float4*)(p.in[I_GLUB] + l * 512 + col0 + lane * 4);
                        TILE_ROWS4(r0) {
                          f32x4 v4_[4]; uint2 yv4[4];
#pragma unroll
                          for (int u = 0; u < 4; ++u) { v4_[u] = tile4(lds, r0 + 8 * u, lane); yv4[u] = *(const uint2*)(ymix + (size_t)(row0 + r0 + 8 * u) * DM + 512 + col0 + lane * 4); }
#pragma unroll
                          for (int u = 0; u < 4; ++u) {
                            const int rr = r0 + 8 * u;
                            const f32x4 v = v4_[u];
                            const uint2 yv = yv4[u];
                            const float y0 = bflo(yv.x) * sigmoidf_(v[0] + bias.x), y1 = bfhi(yv.x) * sigmoidf_(v[1] + bias.y);
                            const float y2 = bflo(yv.y) * sigmoidf_(v[2] + bias.z), y3 = bfhi(yv.y) * sigmoidf_(v[3] + bias.w);
                            st_bf4(zr + (size_t)rr * ZC + col0 + lane * 4, y0, y1, y2, y3);
                            const float s = wave_sum(y0 * y0 + y1 * y1 + y2 * y2 + y3 * y3);
                            if (lane == 0) ssq[rr] += s;
                          }
                        }
                    } else {
                        xadd_rowpass_f(lds, x, row0, col0, lane, wave, xwr);
                    }
                    __syncthreads();
                }
            } else if (op == OP_SOFTMAX) {
                attn_all(zr, (const bf16_t*)(wsl + WS_KMEM) + (size_t)l * 1024 * 1024 + (size_t)b * 262144, (const bf16_t*)(wsl + WS_VMEMT) + (size_t)l * 1024 * 1024 + (size_t)b * 262144, zr + 1024, lds);
            } else {
                gemm_to_lds<256>((const bf16_t*)A, lda >> 1, (const bf16_t*)Bt, ldb >> 1, KB >> 1, lds);
                if (op == OP_SOFTMAX) {
                    TILE_ROWS(rr) {
                        const f32x4 sv = tile4(lds, rr, lane);
                        const float s0 = sv[0] * 0.0625f, s1 = sv[1] * 0.0625f, s2 = sv[2] * 0.0625f, s3 = sv[3] * 0.0625f;
                        const float m = wave_max(fmaxf(fmaxf(s0, s1), fmaxf(s2, s3)));
                        const float e0 = __expf(s0 - m), e1 = __expf(s1 - m), e2 = __expf(s2 - m), e3 = __expf(s3 - m);
                        const float inv = rcp_(wave_sum(e0 + e1 + e2 + e3));
                        st_bf4(Psc + rr * 256 + lane * 4, e0 * inv, e1 * inv, e2 * inv, e3 * inv);
                    }
                } else {
                    TILE_ROWS(rr) { const f32x4 v = tile4(lds, rr, lane); st_bf4(zr + (size_t)rr * ZC + 1024 + sub * 256 + lane * 4, v[0], v[1], v[2], v[3]); }
                }
            }
            if (!wide || step == 0 || step == 2 || step == 4 || step == 14 || step == 18) block_gsync();
            if (step == 0) {
                const float* og = p.in[I_S5OG] + l * 512 + lane * 8;
                const float4 g0 = *(const float4*)og, g1 = *(const float4*)(og + 4);
                TILE_ROWS4(r0) {
                  uint4 yv4[4];
#pragma unroll
                  for (int u = 0; u < 4; ++u) yv4[u] = *(const uint4*)(zr + (size_t)(r0 + 8 * u) * ZC + lane * 8);
#pragma unroll
                  for (int u = 0; u < 4; ++u) {
                    const int rr = r0 + 8 * u;
                    const uint4 yv = yv4[u];
                    const float r = __builtin_amdgcn_rsqf(ssq[rr] * (1.0f / 512.f) + RMS_EPS);
                    uint4 o;
                    o.x = pack2(bflo(yv.x) * r * g0.x, bfhi(yv.x) * r * g0.y); o.y = pack2(bflo(yv.y) * r * g0.z, bfhi(yv.y) * r * g0.w);
                    o.z = pack2(bflo(yv.z) * r * g1.x, bfhi(yv.z) * r * g1.y); o.w = pack2(bflo(yv.w) * r * g1.z, bfhi(yv.w) * r * g1.w);
                    if (xwr) *(uint4*)(ymix + (size_t)(row0 + rr) * DM + 512 + lane * 8) = o;
                  }
                }
                block_gsync();
            }
            if (step == 2 || step == 14) { quant_rows_x(x + (size_t)row0 * DM, xqr, lds, lane, wave); block_gsync(); }
        }
    }
}

__global__ void __launch_bounds__(NTHREADS, 2) fwd_kernel(Params p) {
    extern __shared__ __attribute__((aligned(16))) unsigned char lds_raw[];
    ldsp lds = (ldsp)lds_raw;
    const int tid = threadIdx.x;
    volatile LAS unsigned* st = (volatile LAS unsigned*)(lds + LDS_ST);
    if (tid < 4) st[tid] = 0u;
    __syncthreads();
    XcdBarrier bar = xcd_barrier_post((unsigned*)(p.ws + WS_CTL), st);
#ifndef ONLY
#define ONLY 0xff
#endif
#pragma unroll 1
    for (int rep = 0; rep < ((PROBE & 1) ? 2 : 1); ++rep) { if (ONLY & 1) p0_prep(p, lds); xcd_barrier(bar); }
    p0b_quant_weights(p);
    xcd_barrier(bar);
#pragma unroll 1
    for (int rep = 0; rep < ((PROBE & 2) ? 2 : 1); ++rep) { if (ONLY & 2) phase_a(p, 0, true, lds); xcd_barrier(bar); }
#pragma unroll 1
    for (int l = 0; l < NL; ++l) {
#pragma unroll 1
        for (int rep = 0; rep < ((PROBE & 4) ? 2 : 1); ++rep) { if (ONLY & 4) phase_bd(p, l, 0, lds); xcd_barrier(bar); }
#pragma unroll 1
        for (int crep = 0; crep < ((PROBE & 1048576) ? 2 : 1); ++crep) { if (crep) xcd_barrier(bar);
        if (ONLY & 16) phase_c(p, l, lds, (PROBE & 1048576) ? (crep == 1) : true); }
        xcd_barrier(bar);
#pragma unroll 1
        for (int rep = 0; rep < ((PROBE & 8) ? 2 : 1); ++rep) { if (ONLY & 4) phase_bd(p, l, 1, lds); xcd_barrier(bar); }
#pragma unroll 1
        for (int erep = 0; erep < ((PROBE & 524288) ? 2 : 1); ++erep) { if (erep) xcd_barrier(bar);
        if (ONLY & 8) phase_e(p, l, lds, bar, erep); }
        if (l + 1 < NL) xcd_barrier(bar);
    }
}

extern "C" void kernel_launch(void* const* d_in, const int* in_sizes, int n_in, void* d_out, int out_size,
                              void* d_ws, size_t ws_size, hipStream_t stream) {
    constexpr size_t kDynLds = LDS_TOTAL;
    static int grid = 0;
    if (!grid) {
        int dev = 0, cus = 0, per_cu = 0;
        (void)hipGetDevice(&dev);
        (void)hipDeviceGetAttribute(&cus, hipDeviceAttributeMultiprocessorCount, dev);
        (void)hipFuncSetAttribute((const void*)fwd_kernel, hipFuncAttributeMaxDynamicSharedMemorySize, (int)kDynLds);
        (void)hipOccupancyMaxActiveBlocksPerMultiprocessor(&per_cu, (const void*)fwd_kernel, NTHREADS, kDynLds);
        if (per_cu < 1) { fprintf(stderr, "occupancy query says %d blocks/CU\n", per_cu); per_cu = 1; }
        grid = cus;
        if (grid > 256) grid = 256;
        fprintf(stderr, "kernel_launch: cus=%d per_cu=%d grid=%d ws=%zu need=%zu n_in=%d\n", cus, per_cu, grid, ws_size, (size_t)WS_END, n_in);
    }
    if (ws_size < WS_END || n_in < N_IN) { fprintf(stderr, "workspace too small / bad inputs\n"); return; }
    (void)hipMemsetAsync((char*)d_ws + WS_CTL, 0, XCD_BAR_WORDS * 4, stream);
    Params p{};
    for (int i = 0; i < N_IN; ++i) p.in[i] = (const float*)d_in[i];
    p.out = (float*)d_out; p.ws = (unsigned char*)d_ws; p.ph_lo = 0; p.ph_hi = 100;
    void* args[] = {&p};
    hipError_t e = hipLaunchCooperativeKernel((const void*)fwd_kernel, dim3(grid), dim3(NTHREADS), args, kDynLds, stream);
    if (e != hipSuccess) fprintf(stderr, "cooperative launch failed: %s (grid %d)\n", hipGetErrorString(e), grid);
}
```

```cpp
#include <hip/hip_runtime.h>
#include <hip/hip_bf16.h>
#include <cstdio>
#include <cstdint>

#define NTHREADS 512
#ifndef PROBE
#define PROBE 0
#endif
#define LAS __attribute__((address_space(3)))
typedef unsigned short bf16_t;
typedef LAS unsigned char* ldsp;
using bf16x8 = __attribute__((ext_vector_type(8))) short;
using f32x16 = __attribute__((ext_vector_type(16))) float;
using f32x4  = __attribute__((ext_vector_type(4))) float;
using u32x4  = __attribute__((ext_vector_type(4))) unsigned;
using i32x4  = __attribute__((ext_vector_type(4))) int;
using i32x16 = __attribute__((ext_vector_type(16))) int;

constexpr int T_TOK = 32768, SEQ = 8192, NB = 4, DM = 1024, NL = 2;
constexpr int ZC = 2368;
constexpr int ZN0 = 2304, ZN1 = 2336;
constexpr int NCH = 128;
constexpr float RMS_EPS = 1e-6f, GN_EPS = 64e-5f;
constexpr int LDS_TOTAL = 163840;
constexpr int LDS_ST = LDS_TOTAL - 16;
constexpr int LDS_RSL = LDS_TOTAL - 1024;
constexpr int L_SXL = LDS_TOTAL - 2560;
constexpr int L_SAL = LDS_TOTAL - 3072;

enum { I_X = 0, I_MEM, I_NORM_MIX, I_W_IN, I_MU, I_W0, I_W2, I_A0, I_A2, I_G2, I_KK, I_KA, I_RK, I_V0, I_V1, I_V2, I_LNG, I_LNB,
       I_S5ARE, I_S5AIM, I_S5DT, I_S5BRE, I_S5BIM, I_S5CRE, I_S5CIM, I_S5D, I_GLUW, I_GLUB, I_S5OG, I_WOUT, I_NXA, I_NMEM,
       I_WQ, I_WK, I_WV, I_WO, I_NFFN, I_PWQ, I_PKEYS, I_PU, I_PV, I_NFIN, N_IN };

constexpr size_t al256(size_t x) { return (x + 255) & ~(size_t)255; }
constexpr size_t WS_CTL   = 0;
constexpr size_t WS_WT    = 65536;
constexpr size_t WO_WIN   = 0;
constexpr size_t WO_GLU   = WO_WIN  + (size_t)2560 * 1024 * 2;
constexpr size_t WO_WOUT  = WO_GLU  + (size_t)512 * 512 * 2;
constexpr size_t WO_WQ    = WO_WOUT + (size_t)1024 * 1024 * 2;
constexpr size_t WO_WK    = WO_WQ   + (size_t)1024 * 1024 * 2;
constexpr size_t WO_WV    = WO_WK   + (size_t)1024 * 1024 * 2;
constexpr size_t WO_WO    = WO_WV   + (size_t)1024 * 1024 * 2;
constexpr size_t WO_WPQ   = WO_WO   + (size_t)1024 * 1024 * 2;
constexpr size_t WO_KEYS  = WO_WPQ  + (size_t)2048 * 1024 * 2;
constexpr size_t WO_W2T   = WO_KEYS + (size_t)16 * 128 * 128 * 2;
constexpr size_t WO_A2T   = WO_W2T  + (size_t)512 * 64 * 2;
constexpr size_t WO_G2T   = WO_A2T  + (size_t)512 * 64 * 2;
constexpr size_t WO_V2T   = WO_G2T  + (size_t)512 * 128 * 2;
constexpr size_t WO_BBAR  = WO_V2T  + (size_t)512 * 32 * 2;
constexpr size_t WO_LAM   = WO_BBAR + (size_t)32 * 64 * 32 * 4;
constexpr size_t WO_CMAT  = WO_LAM  + (size_t)32 * 64 * 4 * 4;
constexpr size_t WO_SU    = WO_CMAT + (size_t)32 * 16 * 128 * 2;
constexpr size_t WO_SV    = WO_SU + (size_t)16384 * 4;
constexpr size_t WO_BB2   = WO_SV + (size_t)16384 * 4;
constexpr size_t WO_SW    = WO_BB2 + (size_t)32 * 128 * 16 * 2;
constexpr int SW_WIN = 0, SW_WOUT = 2560, SW_WQ = 3584, SW_WO = 4608, SW_WPQ = 5632, SW_TOTAL = 7680;
constexpr size_t WT_LAYER = al256(WO_SW + (size_t)SW_TOTAL * 4);
constexpr size_t WS_MEMB  = WS_WT + NL * WT_LAYER;
constexpr size_t WS_KMEM  = WS_MEMB + (size_t)1024 * 1024 * 2;
constexpr size_t WS_VMEMT = WS_KMEM + (size_t)NL * 1024 * 1024 * 2;
constexpr size_t WS_RS    = WS_VMEMT + (size_t)NL * 1024 * 1024 * 2;
constexpr size_t WS_UB    = WS_RS + (size_t)T_TOK * 4;
constexpr size_t WS_VB    = WS_UB + (size_t)NL * 16384 * 1024;
constexpr size_t WS_XB    = WS_VB + (size_t)NL * 16384 * 1024;
constexpr size_t WS_XQ    = WS_XB;
constexpr size_t WS_SX    = WS_XQ + (size_t)T_TOK * 1024;
constexpr size_t WS_W8    = al256(WS_SX + (size_t)T_TOK * 4);
constexpr size_t W8_WIN = 0, W8_WQ = (size_t)5 * 524288, W8_WO = W8_WQ + (size_t)2 * 524288, W8_WPQ = W8_WO + (size_t)2 * 524288, W8_LAYER = W8_WPQ + (size_t)4 * 524288;
static_assert(WS_W8 + NL * W8_LAYER <= WS_XB + (size_t)T_TOK * 1024 * 2, "tiled int8 weights overflow the XB region");
constexpr size_t WS_Z     = WS_XB + (size_t)T_TOK * 1024 * 2;
constexpr size_t WS_YMIX  = WS_Z + (size_t)T_TOK * ZC * 2;
constexpr size_t WS_VFIRST= WS_YMIX + (size_t)T_TOK * 1024 * 2;
constexpr size_t WS_SCR   = WS_VFIRST + (size_t)T_TOK * 512 * 2;
constexpr size_t SCR_BLK  = 327680;
constexpr size_t WS_END   = WS_SCR + (size_t)256 * SCR_BLK;

typedef __bf16 bf2_t __attribute__((ext_vector_type(2)));
__device__ __forceinline__ bf16_t f2bf(float f) { return __builtin_bit_cast(unsigned short, (__bf16)f); }
__device__ __forceinline__ float bf2f(bf16_t h) { return __uint_as_float((unsigned)h << 16); }
__device__ __forceinline__ float bflo(unsigned w) { return __uint_as_float(w << 16); }
__device__ __forceinline__ float bfhi(unsigned w) { return __uint_as_float(w & 0xffff0000u); }
__device__ __forceinline__ unsigned pack2(float a, float b) { bf2_t v; v[0] = (__bf16)a; v[1] = (__bf16)b; return __builtin_bit_cast(unsigned, v); }
__device__ __forceinline__ void unpack8(const u32x4 w, float* f) { f[0] = bflo(w[0]); f[1] = bfhi(w[0]); f[2] = bflo(w[1]); f[3] = bfhi(w[1]); f[4] = bflo(w[2]); f[5] = bfhi(w[2]); f[6] = bflo(w[3]); f[7] = bfhi(w[3]); }
__device__ __forceinline__ float rcp_(float x) { return __builtin_amdgcn_rcpf(x); }
__device__ __forceinline__ float sigmoidf_(float x) { return rcp_(1.0f + __expf(-x)); }
__device__ __forceinline__ float tanh_(float y) { return 1.0f - 2.0f * rcp_(__expf(2.0f * y) + 1.0f); }
__device__ __forceinline__ float gelu_(float x) { return 0.5f * x * (1.0f + tanh_(0.7978845608028654f * (x + 0.044715f * x * x * x))); }
__device__ __forceinline__ float softplus_(float x) { return fmaxf(x, 0.f) + __logf(1.0f + __expf(-fabsf(x))); }

template <int C> __device__ __forceinline__ float dppf(float v) {
    return __int_as_float(__builtin_amdgcn_update_dpp(__float_as_int(v), __float_as_int(v), C, 0xf, 0xf, false));
}
__device__ __forceinline__ float row16_sum(float v) { v += dppf<0xB1>(v); v += dppf<0x4E>(v); v += dppf<0x141>(v); v += dppf<0x140>(v); return v; }
__device__ __forceinline__ float row16_max(float v) { v = fmaxf(v, dppf<0xB1>(v)); v = fmaxf(v, dppf<0x4E>(v)); v = fmaxf(v, dppf<0x141>(v)); v = fmaxf(v, dppf<0x140>(v)); return v; }
__device__ __forceinline__ float grp8_sum(float v) { v += dppf<0xB1>(v); v += dppf<0x4E>(v); v += dppf<0x141>(v); return v; }
__device__ __forceinline__ float rl(float v, int l) { return __int_as_float(__builtin_amdgcn_readlane(__float_as_int(v), l)); }
__device__ __forceinline__ float wave_sum(float v) { v = row16_sum(v); return (rl(v, 0) + rl(v, 16)) + (rl(v, 32) + rl(v, 48)); }
template <int C> __device__ __forceinline__ int dppi(int v) { return __builtin_amdgcn_update_dpp(v, v, C, 0xf, 0xf, false); }
__device__ __forceinline__ int wave_sum_i(int v) {
    v += dppi<0xB1>(v); v += dppi<0x4E>(v); v += dppi<0x141>(v); v += dppi<0x140>(v);
    return (__builtin_amdgcn_readlane(v, 0) + __builtin_amdgcn_readlane(v, 16)) + (__builtin_amdgcn_readlane(v, 32) + __builtin_amdgcn_readlane(v, 48));
}
__device__ __forceinline__ int row16_sum_i(int v) { v += dppi<0xB1>(v); v += dppi<0x4E>(v); v += dppi<0x141>(v); v += dppi<0x140>(v); return v; }
__device__ __forceinline__ float wave_max(float v) { v = row16_max(v); return fmaxf(fmaxf(rl(v, 0), rl(v, 16)), fmaxf(rl(v, 32), rl(v, 48))); }

#define XB_TMO      128
#define XB_XCNT(j)  (256  + 64 * (j))
#define XB_XSUB(j)  (1280 + 64 * (j))
#define XB_XGEN(j)  (2304 + 64 * (j))
#define XB_TOP      3328
#define XB_TOPGEN   3392
#define XCD_BAR_WORDS 3456
#define XB_SPIN_CAP (1u << 24)
__device__ __forceinline__ unsigned xb_ld(unsigned* p)              { return __hip_atomic_load(p, __ATOMIC_RELAXED, __HIP_MEMORY_SCOPE_AGENT); }
__device__ __forceinline__ unsigned xb_add(unsigned* p, unsigned v) { return __hip_atomic_fetch_add(p, v, __ATOMIC_RELAXED, __HIP_MEMORY_SCOPE_AGENT); }
__device__ __forceinline__ unsigned xb_xcc_id() { return (unsigned)__builtin_amdgcn_s_getreg((3 << 11) | 20) & 0xFu; }
#define XB_SPIN(cond, bar) do { unsigned _sp = 0; while (cond) { __builtin_amdgcn_s_sleep(1); \
    if ((++_sp & 255u) == 0u) { if (xb_ld(&(bar)[XB_TMO])) break; if (_sp > XB_SPIN_CAP) { atomicAdd(&(bar)[XB_TMO], 1u); break; } } } } while (0)
struct XcdBarrier { unsigned* bar; unsigned x; volatile LAS unsigned* st; };
__device__ __forceinline__ XcdBarrier xcd_barrier_post(unsigned* bar, volatile LAS unsigned* st) {
    XcdBarrier b; b.bar = bar; b.x = xb_xcc_id(); b.st = st;
    if (threadIdx.x == 0) (void)xb_add(&bar[XB_XCNT(b.x)], 1u);
    return b;
}
__device__ __forceinline__ void xcd_barrier_complete(unsigned* bar, unsigned x, unsigned& nloc, unsigned& nx) {
    const unsigned G = gridDim.x * gridDim.y * gridDim.z;
    unsigned sum, cnt, mine, sp = 0u;
    for (;;) {
        sum = 0u; cnt = 0u; mine = 0u;
#pragma unroll
        for (unsigned j = 0; j < 16; ++j) { const unsigned c = xb_ld(&bar[XB_XCNT(j)]); sum += c; cnt += (c > 0u) ? 1u : 0u; mine = (j == x) ? c : mine; }
        if (sum == G) break;
        __builtin_amdgcn_s_sleep(1);
        if ((++sp & 255u) == 0u) { if (xb_ld(&bar[XB_TMO])) break; if (sp > XB_SPIN_CAP) { atomicAdd(&bar[XB_TMO], 1u); break; } }
    }
    nloc = mine > 0u ? mine : 1u; nx = cnt > 0u ? cnt : 1u;
}
__device__ __forceinline__ void xcd_barrier(const XcdBarrier& b) {
    asm volatile("s_waitcnt vmcnt(0)" ::: "memory");
    __syncthreads();
    if (threadIdx.x == 0) {
        unsigned* bar = b.bar;
        __builtin_amdgcn_s_waitcnt(0);
        unsigned nloc = b.st[0], nx = b.st[1];
        if (nloc == 0u) { xcd_barrier_complete(bar, b.x, nloc, nx); b.st[0] = nloc; b.st[1] = nx; }
        const unsigned old = xb_add(&bar[XB_XSUB(b.x)], 1u);
        const unsigned gen = old / nloc;
        if (old + 1u == (gen + 1u) * nloc) {
            __builtin_amdgcn_fence(__ATOMIC_RELEASE, "agent");
            asm volatile("s_waitcnt vmcnt(0)" ::: "memory");
            const unsigned og = xb_add(&bar[XB_TOP], 1u);
            const unsigned tg = og / nx;
            if (og + 1u == (tg + 1u) * nx) xb_add(&bar[XB_TOPGEN], 1u);
            else XB_SPIN(xb_ld(&bar[XB_TOPGEN]) == tg, bar);
            __builtin_amdgcn_fence(__ATOMIC_ACQUIRE, "agent");
            xb_add(&bar[XB_XGEN(b.x)], 1u);
            asm volatile("s_waitcnt vmcnt(0)" ::: "memory");
        } else {
            XB_SPIN(xb_ld(&bar[XB_XGEN(b.x)]) == gen, bar);
            __builtin_amdgcn_fence(__ATOMIC_ACQUIRE, "agent");
            asm volatile("s_waitcnt vmcnt(0)" ::: "memory");
        }
    }
    __syncthreads();
}

struct Params {
    const float* in[N_IN];
    float* out;
    unsigned char* ws;
    int ph_lo, ph_hi;
};

__device__ __forceinline__ int tid_opaque() { int t = threadIdx.x; asm volatile("" : "+v"(t)); return t; }
__device__ __forceinline__ int bid_opaque() { int b = __builtin_amdgcn_readfirstlane(blockIdx.x); asm volatile("" : "+s"(b)); return b; }
__device__ __forceinline__ unsigned char* ptr_opaque(unsigned char* ptr) {
    unsigned lo = __builtin_amdgcn_readfirstlane((unsigned)(unsigned long long)ptr), hi = __builtin_amdgcn_readfirstlane((unsigned)((unsigned long long)ptr >> 32));
    asm volatile("" : "+s"(lo), "+s"(hi));
    typedef __attribute__((address_space(1))) unsigned char* gptr_t;
    unsigned char* r = (unsigned char*)(gptr_t)(((unsigned long long)hi << 32) | lo);
    return r;
}
__device__ __forceinline__ void block_gsync() { asm volatile("s_waitcnt vmcnt(0)" ::: "memory"); __syncthreads(); }

__device__ __forceinline__ int swz(int row, int slot) { return row * 128 + (((slot ^ (row >> 1)) & 7) << 4); }

template <int BN>
__device__ __forceinline__ void gemm_to_lds(const bf16_t* __restrict__ A, int lda, const bf16_t* __restrict__ Bt, int ldb, int K, ldsp lds) {
    constexpr int NI = BN / 128;
    constexpr int BCH = BN / 64;
    constexpr int STAGE = 16384 + BN * 128;
    constexpr int TS = (BN == 128) ? 129 : BN + 4;
    int tid = threadIdx.x;
    asm volatile("" : "+v"(tid));
    const int lane = tid & 63, wave = tid >> 6;
    const int wvu = __builtin_amdgcn_readfirstlane(wave);
    const int wm = wave >> 2, wn = wave & 3;
    const int fr = lane & 31, fh = lane >> 5;
    f32x16 acc[2][NI];
#pragma unroll
    for (int mi = 0; mi < 2; ++mi)
#pragma unroll
        for (int ni = 0; ni < NI; ++ni)
#pragma unroll
            for (int r = 0; r < 16; ++r) acc[mi][ni][r] = 0.f;
    const int crow = tid >> 3;
    const int lslot = (tid & 7) ^ ((crow >> 1) & 7);
    const bf16_t* Ag = A + (size_t)crow * lda + lslot * 8;
    const bf16_t* Bg = Bt + (size_t)crow * ldb + lslot * 8;
    unsigned char* ldg = (unsigned char*)lds;
    const int nk = K >> 6;
#define GEMM_ISSUE(kt_, st_) do { \
        _Pragma("unroll") for (int j = 0; j < 2; ++j) \
            __builtin_amdgcn_global_load_lds((const unsigned*)(Ag + (size_t)(64 * j) * lda + (kt_) * 64), (LAS unsigned*)(lds + (st_) * STAGE + j * 8192 + wvu * 1024), 16, 0, 0); \
        _Pragma("unroll") for (int j = 0; j < BCH; ++j) \
            __builtin_amdgcn_global_load_lds((const unsigned*)(Bg + (size_t)(64 * j) * ldb + (kt_) * 64), (LAS unsigned*)(lds + (st_) * STAGE + 16384 + j * 8192 + wvu * 1024), 16, 0, 0); \
    } while (0)
    (void)ldg;
    GEMM_ISSUE(0, 0);
    if (nk > 1) GEMM_ISSUE(1, 1);
    int st = 0;
#pragma unroll 1
    for (int kt = 0; kt < nk; ++kt) {
        if (kt + 1 < nk) { if constexpr (BN == 256) asm volatile("s_waitcnt vmcnt(6)" ::: "memory"); else asm volatile("s_waitcnt vmcnt(4)" ::: "memory"); }
        else asm volatile("s_waitcnt vmcnt(0)" ::: "memory");
        asm volatile("s_waitcnt lgkmcnt(0)" ::: "memory");
        __builtin_amdgcn_s_barrier();
        ldsp base = lds + st * STAGE;
        bf16x8 a[4][2], b[4][NI];
#pragma unroll
        for (int kk = 0; kk < 4; ++kk) {
#pragma unroll
            for (int mi = 0; mi < 2; ++mi) a[kk][mi] = *(LAS bf16x8*)(base + swz(wm * 64 + mi * 32 + fr, kk * 2 + fh));
#pragma unroll
            for (int ni = 0; ni < NI; ++ni) b[kk][ni] = *(LAS bf16x8*)(base + 16384 + swz(wn * (BN / 4) + ni * 32 + fr, kk * 2 + fh));
        }
        if (kt + 2 < nk) { const int s2 = (st == 0) ? 2 : st - 1; GEMM_ISSUE(kt + 2, s2); }
#pragma unroll
        for (int kk = 0; kk < 4; ++kk)
#pragma unroll
            for (int mi = 0; mi < 2; ++mi)
#pragma unroll
                for (int ni = 0; ni < NI; ++ni) acc[mi][ni] = __builtin_amdgcn_mfma_f32_32x32x16_bf16(a[kk][mi], b[kk][ni], acc[mi][ni], 0, 0, 0);
        st = (st == 2) ? 0 : st + 1;
    }
#undef GEMM_ISSUE
    asm volatile("s_waitcnt lgkmcnt(0)" ::: "memory");
    __builtin_amdgcn_s_barrier();
    LAS float* tile = (LAS float*)lds;
#pragma unroll
    for (int mi = 0; mi < 2; ++mi)
#pragma unroll
        for (int ni = 0; ni < NI; ++ni) {
            LAS float* tp = tile + (wm * 64 + mi * 32 + 4 * fh) * TS + wn * (BN / 4) + ni * 32 + fr;
#pragma unroll
            for (int r = 0; r < 16; ++r) tp[((r & 3) + 8 * (r >> 2)) * TS] = acc[mi][ni][r];
        }
    __syncthreads();
}

__device__ __forceinline__ void dma16_asm(const void* g, unsigned lds_addr) {
    unsigned m0s;
    asm volatile("s_mov_b32 %0, m0\n\ts_mov_b32 m0, %1\n\ts_nop 0\n\tglobal_load_lds_dwordx4 %2, off\n\ts_mov_b32 m0, %0" : "=&s"(m0s) : "s"(lds_addr), "v"(g) : "memory");
}
__device__ __forceinline__ void dma16_asm_sc1(const void* g, unsigned lds_addr) {
    unsigned m0s;
    asm volatile("s_mov_b32 %0, m0\n\ts_mov_b32 m0, %1\n\ts_nop 0\n\tglobal_load_lds_dwordx4 %2, off sc1\n\ts_mov_b32 m0, %0" : "=&s"(m0s) : "s"(lds_addr), "v"(g) : "memory");
}

__device__ __forceinline__ int swz4(int row, int slot) { return row * 64 + (((slot ^ (row >> 2)) & 3) << 4); }
template <bool I8> struct AccSel { using T = f32x16; };
template <> struct AccSel<true> { using T = i32x16; };
template <bool I8>
__device__ __forceinline__ void gemm512_acc(const unsigned char* __restrict__ A, int lda, const unsigned char* __restrict__ Bt, int ldb, int kst, int KB, ldsp lds, typename AccSel<I8>::T (&acc)[2][4]) {
    constexpr int BST = 32768, AST = 8192, AOFF = 4 * BST;
    int tid = threadIdx.x;
    asm volatile("" : "+v"(tid));
    const int lane = tid & 63, wave = tid >> 6;
    const int wvu = __builtin_amdgcn_readfirstlane(wave);
    const int wm = wave >> 2, wn = wave & 3;
    const int fr = lane & 31, fh = lane >> 5;
#pragma unroll
    for (int mi = 0; mi < 2; ++mi)
#pragma unroll
        for (int ni = 0; ni < 4; ++ni)
#pragma unroll
            for (int r = 0; r < 16; ++r) acc[mi][ni][r] = 0;
    const int drow = wvu * 16 + (lane >> 2);
    const int lslot = (lane & 3) ^ ((drow >> 2) & 3);
    const unsigned char* Ag = A + (size_t)drow * lda + lslot * 16;
    const unsigned char* Bg = Bt + (size_t)drow * ldb + lslot * 16;
    const int nk = KB >> 6;
    const unsigned lb = __builtin_amdgcn_readfirstlane((unsigned)(size_t)lds + wvu * 1024);
    const int krot = (int)(blockIdx.x >> 3), kmask = nk - 1;
#define G5_ISSUE_A(kt_, sa_) dma16_asm(Ag + ((((kt_) + krot) & kmask)) * 64, lb + AOFF + (sa_) * AST)
#define G5_ISSUE_B(kt_, sb_) do { _Pragma("unroll") for (int j = 0; j < 4; ++j) \
            dma16_asm_sc1(Bg + (size_t)(128 * j) * ldb + (size_t)(((kt_) + krot) & kmask) * kst, lb + (sb_) * BST + j * 8192); } while (0)
#define G5_RDH(a_, b_, bA_, bB_, kk_) do { \
        a_[0] = *(LAS bf16x8*)((bA_) + swz4(wm * 64 + fr, (kk_) * 2 + fh)); \
        _Pragma("unroll") for (int ni = 0; ni < 4; ++ni) b_[ni] = *(LAS bf16x8*)((bB_) + swz4((ni >> 1) * 256 + wn * 64 + (ni & 1) * 32 + fr, (kk_) * 2 + fh)); \
        a_[1] = *(LAS bf16x8*)((bA_) + swz4(wm * 64 + 32 + fr, (kk_) * 2 + fh)); } while (0)
#define G5_MMH(a_, b_) do { _Pragma("unroll") for (int mi = 0; mi < 2; ++mi) _Pragma("unroll") for (int ni = 0; ni < 4; ++ni) { \
        if constexpr (I8) acc[mi][ni] = __builtin_amdgcn_mfma_i32_32x32x32_i8(__builtin_bit_cast(i32x4, a_[mi]), __builtin_bit_cast(i32x4, b_[ni]), acc[mi][ni], 0, 0, 0); \
        else acc[mi][ni] = __builtin_amdgcn_mfma_f32_32x32x16_bf16(a_[mi], b_[ni], acc[mi][ni], 0, 0, 0); } } while (0)
#define G5_SG1() do { __builtin_amdgcn_sched_group_barrier(0x008, 1, 0); __builtin_amdgcn_sched_group_barrier(0x100, 1, 0); } while (0)
#define G5_SCHED() do { G5_SG1(); G5_SG1(); G5_SG1(); G5_SG1(); G5_SG1(); G5_SG1(); __builtin_amdgcn_sched_group_barrier(0x008, 2, 0); } while (0)
    G5_ISSUE_B(0, 0); G5_ISSUE_A(0, 0); G5_ISSUE_B(1, 1); G5_ISSUE_A(1, 1); G5_ISSUE_B(2, 2); G5_ISSUE_A(2, 2); G5_ISSUE_B(3, 3);
    asm volatile("s_waitcnt vmcnt(14)" ::: "memory");
    asm volatile("s_waitcnt lgkmcnt(0)" ::: "memory");
    __builtin_amdgcn_s_barrier();
    bf16x8 xa[2], xb[4], ya[2], yb[4];
    G5_RDH(xa, xb, lds + AOFF, lds, 0);
    int sa = 0;
#pragma unroll 1
    for (int kt = 0; kt + 1 < nk; ++kt) {
        __builtin_amdgcn_sched_barrier(0);
        {
            ldsp baseA = lds + AOFF + sa * AST, baseB = lds + (kt & 3) * BST;
            G5_RDH(ya, yb, baseA, baseB, 1);
            G5_MMH(xa, xb);
            G5_SCHED();
        }
        __builtin_amdgcn_sched_barrier(0);
        if (kt + 3 < nk) asm volatile("s_waitcnt vmcnt(9)" ::: "memory");
        else if (kt + 2 < nk) asm volatile("s_waitcnt vmcnt(5)" ::: "memory");
        else asm volatile("s_waitcnt vmcnt(0)" ::: "memory");
        asm volatile("s_waitcnt lgkmcnt(0)" ::: "memory");
        __builtin_amdgcn_s_barrier();
        if (kt + 3 < nk) G5_ISSUE_A(kt + 3, sa);
        if (kt + 4 < nk) G5_ISSUE_B(kt + 4, kt & 3);
        sa = (sa == 2) ? 0 : sa + 1;
        __builtin_amdgcn_sched_barrier(0);
        {
            ldsp baseA = lds + AOFF + sa * AST, baseB = lds + ((kt + 1) & 3) * BST;
            G5_RDH(xa, xb, baseA, baseB, 0);
            G5_MMH(ya, yb);
            G5_SCHED();
        }
        __builtin_amdgcn_sched_barrier(0);
    }
    {
        ldsp baseA = lds + AOFF + sa * AST, baseB = lds + ((nk - 1) & 3) * BST;
        G5_RDH(ya, yb, baseA, baseB, 1);
        G5_MMH(xa, xb);
        G5_SCHED();
        __builtin_amdgcn_sched_barrier(0);
        G5_MMH(ya, yb);
    }
#undef G5_ISSUE_A
#undef G5_ISSUE_B
#undef G5_RDH
#undef G5_MMH
#undef G5_SG1
#undef G5_SCHED
    asm volatile("s_waitcnt lgkmcnt(0)" ::: "memory");
    __builtin_amdgcn_s_barrier();
}
template <class ACC>
__device__ __forceinline__ void gemm512_store_half(const ACC (&acc)[2][4], int h, ldsp lds) {
    int tid = threadIdx.x;
    asm volatile("" : "+v"(tid));
    const int lane = tid & 63, wave = tid >> 6, wm = wave >> 2, wn = wave & 3, fr = lane & 31, fh = lane >> 5;
    using el_t = decltype(acc[0][0][0] + 0);
    LAS el_t* tile = (LAS el_t*)lds;
#pragma unroll
    for (int mi = 0; mi < 2; ++mi)
#pragma unroll
        for (int n2 = 0; n2 < 2; ++n2) {
            LAS el_t* tp = tile + (wm * 64 + mi * 32 + 4 * fh) * 260 + wn * 64 + n2 * 32 + fr;
#pragma unroll
            for (int r = 0; r < 16; ++r) tp[((r & 3) + 8 * (r >> 2)) * 260] = (h == 0) ? acc[mi][n2][r] : acc[mi][2 + n2][r];
        }
    __syncthreads();
}

template <class Epi>
__device__ __forceinline__ void lds_mm64(ldsp A, int lda, ldsp B, int ldb, int K, Epi epi) {
    const int tid = threadIdx.x, lane = tid & 63, wave = tid >> 6;
    if (wave < 4) {
        const int mi = wave >> 1, ni = wave & 1, fr = lane & 31, fh = lane >> 5;
        f32x16 acc;
#pragma unroll
        for (int r = 0; r < 16; ++r) acc[r] = 0.f;
        for (int kk = 0; kk < (K >> 4); ++kk) {
            bf16x8 a = *(LAS bf16x8*)(A + (mi * 32 + fr) * lda + (kk * 16 + fh * 8) * 2);
            bf16x8 b = *(LAS bf16x8*)(B + (ni * 32 + fr) * ldb + (kk * 16 + fh * 8) * 2);
            acc = __builtin_amdgcn_mfma_f32_32x32x16_bf16(a, b, acc, 0, 0, 0);
        }
#pragma unroll
        for (int r = 0; r < 16; ++r) epi(mi * 32 + (r & 3) + 8 * (r >> 2) + 4 * fh, ni * 32 + fr, acc[r]);
    }
}

struct TMat { const float* src; const float* gain; bf16_t* dst; int K, N, ld_src, ld_dst; };

__device__ __forceinline__ unsigned char* wt_layer(const Params& p, int l) { return p.ws + WS_WT + (size_t)l * WT_LAYER; }

__device__ void p0_transposes(const Params& p, ldsp lds) {
    const int tid = tid_opaque(), G = gridDim.x, bid = bid_opaque();
    TMat* tab = (TMat*)(unsigned char*)(lds + 32768);
    int* pre = (int*)(unsigned char*)(lds + 32768 + 4096);
    constexpr int NMAT = 27;
    if (tid == 0) {
        int n = 0;
        for (int l = 0; l < NL; ++l) {
            unsigned char* W = wt_layer(p, l);
            auto add = [&](const float* s, const float* g, size_t off, int K, int N, int ldd) { TMat m; m.src = s; m.gain = g; m.dst = (bf16_t*)(W + off); m.K = K; m.N = N; m.ld_src = N; m.ld_dst = ldd; tab[n++] = m; };
            add(p.in[I_W_IN] + (size_t)l * 1024 * 2304, p.in[I_NORM_MIX] + l * 1024, WO_WIN, 1024, 2304, 1024);
            add(p.in[I_GLUW] + (size_t)l * 512 * 512, nullptr, WO_GLU, 512, 512, 512);
            add(p.in[I_WOUT] + (size_t)l * 1024 * 1024, nullptr, WO_WOUT, 1024, 1024, 1024);
            add(p.in[I_WQ] + (size_t)l * 1024 * 1024, p.in[I_NXA] + l * 1024, WO_WQ, 1024, 1024, 1024);
            add(p.in[I_WK] + (size_t)l * 1024 * 1024, p.in[I_NMEM] + l * 1024, WO_WK, 1024, 1024, 1024);
            add(p.in[I_WV] + (size_t)l * 1024 * 1024, p.in[I_NMEM] + l * 1024, WO_WV, 1024, 1024, 1024);
            add(p.in[I_WO] + (size_t)l * 1024 * 1024, nullptr, WO_WO, 1024, 1024, 1024);
            add(p.in[I_W2] + (size_t)l * 64 * 512, nullptr, WO_W2T, 64, 512, 64);
            add(p.in[I_A2] + (size_t)l * 64 * 512, nullptr, WO_A2T, 64, 512, 64);
            add(p.in[I_G2] + (size_t)l * 128 * 512, nullptr, WO_G2T, 128, 512, 128);
            if (l == 1) {
                add(p.in[I_V1], p.in[I_NORM_MIX] + 1024, WO_WIN + (size_t)2304 * 1024 * 2, 1024, 32, 1024);
                add(p.in[I_V2], nullptr, WO_V2T, 32, 512, 32);
            }
        }
        int acc = 0;
        for (int i = 0; i < n; ++i) { pre[i] = acc; acc += ((tab[i].K + 63) >> 6) * ((tab[i].N + 63) >> 6); }
        pre[n] = acc; pre[NMAT + 1] = n;
    }
    __syncthreads();
    const int nmat = pre[NMAT + 1];
    const int total = pre[nmat];
    LAS float* tile = (LAS float*)lds;
    auto locate = [&](int u, int& mi, TMat& m, int& k0, int& n0) {
        while (mi + 1 < nmat && pre[mi + 1] <= u) ++mi;
        m = tab[mi];
        const int loc = u - pre[mi];
        const int ntn = (m.N + 63) >> 6;
        k0 = (loc / ntn) * 64; n0 = (loc % ntn) * 64;
    };
    int mi_f = 0, mi_w = 0;
    const int lr = tid >> 4, lc4 = (tid & 15) * 4;
    const int sn = tid >> 3, sk8 = (tid & 7) * 8;
    auto fetch = [&](int u, float4 (&v)[2]) {
        TMat m; int k0, n0; locate(u, mi_f, m, k0, n0);
#pragma unroll
        for (int j = 0; j < 2; ++j) {
            const int k = k0 + lr + 32 * j, n = n0 + lc4;
            float4 x = make_float4(0.f, 0.f, 0.f, 0.f);
            if (k < m.K && n < m.N) { const f32x4 t_ = __builtin_nontemporal_load((const f32x4*)(m.src + (size_t)k * m.ld_src + n)); x = make_float4(t_[0], t_[1], t_[2], t_[3]);     if (m.gain) { const float g = m.gain[k]; x.x *= g; x.y *= g; x.z *= g; x.w *= g; } }
            v[j] = x;
        }
    };
    float4 va[2];
    if (bid < total) fetch(bid, va);
#pragma unroll 1
    for (int u = bid; u < total; u += G) {
#pragma unroll
        for (int j = 0; j < 2; ++j) {
            LAS float* tp = tile + (lr + 32 * j) * 65 + lc4;
            tp[0] = va[j].x; tp[1] = va[j].y; tp[2] = va[j].z; tp[3] = va[j].w;
        }
        __syncthreads();
        if (u + G < total) fetch(u + G, va);
        TMat m; int k0, n0; locate(u, mi_w, m, k0, n0);
        if (n0 + sn < m.N && k0 + sk8 < m.K) {
            u32x4 o;
#pragma unroll
            for (int i = 0; i < 4; ++i) o[i] = pack2(tile[(sk8 + 2 * i) * 65 + sn], tile[(sk8 + 2 * i + 1) * 65 + sn]);
            *(u32x4*)(m.dst + (size_t)(n0 + sn) * m.ld_dst + k0 + sk8) = o;
        }
        __syncthreads();
    }
}

__device__ void p0_fold_pq(const Params& p, ldsp lds);

__device__ void convert_tables(const Params& p, int l, int part, int nparts) {
    const float* u = p.in[I_PU] + (size_t)l * 16384 * 1024;
    const float* v = p.in[I_PV] + (size_t)l * 16384 * 1024;
    const float* g = p.in[I_NFFN] + l * 1024;
    unsigned* ub = (unsigned*)(p.ws + WS_UB + (size_t)l * 16384 * 1024);
    unsigned* vb = (unsigned*)(p.ws + WS_VB + (size_t)l * 16384 * 1024);
    float* su = (float*)(wt_layer(p, l) + WO_SU);
    float* sv = (float*)(wt_layer(p, l) + WO_SV);
    const int tidc = tid_opaque(), lane = tidc & 63, wave = tidc >> 6;
    float4 gg[4];
#pragma unroll
    for (int j = 0; j < 4; ++j) gg[j] = ((const float4*)g)[lane + 64 * j];
#pragma unroll 1
    for (int row = part * 8 + wave; row < 16384; row += nparts * 8) {
        float4 a[4], b[4]; float am = 0.f, bm = 0.f;
#pragma unroll
        for (int j = 0; j < 4; ++j) {
            { const f32x4 t_ = __builtin_nontemporal_load((const f32x4*)(u + (size_t)row * 1024) + lane + 64 * j); a[j] = make_float4(t_[0], t_[1], t_[2], t_[3]); }
            { const f32x4 t_ = __builtin_nontemporal_load((const f32x4*)(v + (size_t)row * 1024) + lane + 64 * j); b[j] = make_float4(t_[0], t_[1], t_[2], t_[3]); }
            a[j].x *= gg[j].x; a[j].y *= gg[j].y; a[j].z *= gg[j].z; a[j].w *= gg[j].w;
            am = fmaxf(am, fmaxf(fmaxf(fabsf(a[j].x), fabsf(a[j].y)), fmaxf(fabsf(a[j].z), fabsf(a[j].w))));
            bm = fmaxf(bm, fmaxf(fmaxf(fabsf(b[j].x), fabsf(b[j].y)), fmaxf(fabsf(b[j].z), fabsf(b[j].w))));
        }
        am = wave_max(am); bm = wave_max(bm);
        const float ia = am > 0.f ? 127.0f / am : 0.f, ib = bm > 0.f ? 127.0f / bm : 0.f;
#pragma unroll
        for (int j = 0; j < 4; ++j) {
            const int q0 = (int)rintf(a[j].x * ia), q1 = (int)rintf(a[j].y * ia), q2 = (int)rintf(a[j].z * ia), q3 = (int)rintf(a[j].w * ia);
            ub[(size_t)row * 256 + lane + 64 * j] = (unsigned)(q0 & 255) | ((unsigned)(q1 & 255) << 8) | ((unsigned)(q2 & 255) << 16) | ((unsigned)(q3 & 255) << 24);
            const int r0 = (int)rintf(b[j].x * ib) & 255, r1 = (int)rintf(b[j].y * ib) & 255, r2 = (int)rintf(b[j].z * ib) & 255, r3 = (int)rintf(b[j].w * ib) & 255;
            { const int d = lane + 64 * j;
              vb[(size_t)(d >> 5) * (16384 * 32) + (size_t)row * 32 + (d & 31)] = (unsigned)r0 | ((unsigned)r1 << 8) | ((unsigned)r2 << 16) | ((unsigned)r3 << 24); }
        }
        if (lane == 0) { su[row] = am * (1.0f / 127.0f); sv[row] = bm * (1.0f / 127.0f); }
    }
}

__device__ void p0_prep(const Params& p, ldsp lds) {
    const int tid = tid_opaque(), lane = tid & 63, wave = tid >> 6, G = gridDim.x, bid = bid_opaque();
    {
        const float* x = p.in[I_X]; float* xo = p.out; unsigned* xq = (unsigned*)(p.ws + WS_XQ); float* rs = (float*)(p.ws + WS_RS); float* sx = (float*)(p.ws + WS_SX);
#pragma unroll 1
        for (int row = (G == 256) ? T_TOK : bid * 8 + wave; row < T_TOK; row += G * 16) {
            const int row2 = row + G * 8;
            const bool has2 = row2 < T_TOK;
            float4 v[2][4];
#pragma unroll
            for (int j = 0; j < 4; ++j) v[0][j] = ((const float4*)(x + (size_t)row * DM))[lane + 64 * j];
#pragma unroll
            for (int j = 0; j < 4; ++j) v[1][j] = has2 ? ((const float4*)(x + (size_t)row2 * DM))[lane + 64 * j] : make_float4(0.f, 0.f, 0.f, 0.f);
#pragma unroll
            for (int q = 0; q < 2; ++q) {
                const int rw = q ? row2 : row;
                if (q && !has2) break;
                float ss = 0.f, am = 0.f;
#pragma unroll
                for (int j = 0; j < 4; ++j) {
                    ss += v[q][j].x * v[q][j].x + v[q][j].y * v[q][j].y + v[q][j].z * v[q][j].z + v[q][j].w * v[q][j].w;
                    am = fmaxf(am, fmaxf(fmaxf(fabsf(v[q][j].x), fabsf(v[q][j].y)), fmaxf(fabsf(v[q][j].z), fabsf(v[q][j].w))));
                }
                ss = wave_sum(ss); am = wave_max(am);
                const float ia = am > 0.f ? 127.0f / am : 0.f;
#pragma unroll
                for (int j = 0; j < 4; ++j) {
                    ((float4*)(xo + (size_t)rw * DM))[lane + 64 * j] = v[q][j];
                    const int q0 = (int)rintf(v[q][j].x * ia), q1 = (int)rintf(v[q][j].y * ia), q2 = (int)rintf(v[q][j].z * ia), q3 = (int)rintf(v[q][j].w * ia);
                    xq[(size_t)rw * 256 + lane + 64 * j] = (unsigned)(q0 & 255) | ((unsigned)(q1 & 255) << 8) | ((unsigned)(q2 & 255) << 16) | ((unsigned)(q3 & 255) << 24);
                }
                if (lane == 0) { rs[rw] = __builtin_amdgcn_rsqf(ss * (1.0f / DM) + RMS_EPS); sx[rw] = am * (1.0f / 127.0f); }
            }
        }
    }
    {
        const float* m = p.in[I_MEM]; bf16_t* mb = (bf16_t*)(p.ws + WS_MEMB);
        for (int row = bid * 8 + wave; row < NB * 256; row += G * 8) {
            float ss = 0.f; float4 v[4];
#pragma unroll
            for (int j = 0; j < 4; ++j) { v[j] = ((const float4*)(m + (size_t)row * DM))[lane + 64 * j]; ss += v[j].x * v[j].x + v[j].y * v[j].y + v[j].z * v[j].z + v[j].w * v[j].w; }
            ss = wave_sum(ss);
            const float r = __builtin_amdgcn_rsqf(ss * (1.0f / DM) + RMS_EPS);
#pragma unroll
            for (int j = 0; j < 4; ++j) { uint2 o; o.x = pack2(v[j].x * r, v[j].y * r); o.y = pack2(v[j].z * r, v[j].w * r); ((uint2*)(mb + (size_t)row * DM))[lane + 64 * j] = o; }
        }
    }
    p0_transposes(p, lds);
    __syncthreads();
    p0_fold_pq(p, lds);
    {
        uint4* d = (uint4*)(wt_layer(p, 1) + WO_WIN + (size_t)2336 * 1024 * 2);
        const size_t n = (size_t)(2560 - 2336) * 1024 * 2 / 16;
        for (size_t i = (size_t)bid * NTHREADS + tid; i < n; i += (size_t)G * NTHREADS) d[i] = make_uint4(0, 0, 0, 0);
    }
    for (int l = 0; l < NL; ++l) {
        const float* k = p.in[I_PKEYS] + (size_t)l * 16 * 128 * 128; bf16_t* kb = (bf16_t*)(wt_layer(p, l) + WO_KEYS);
        for (int i = bid * NTHREADS + tid; i < 16 * 128 * 128; i += G * NTHREADS) kb[i] = f2bf(k[i]);
    }
    for (int j = bid * NTHREADS + tid; j < NL * 32 * 64 * 16; j += G * NTHREADS) {
        const int i = j >> 4, c = j & 15;
        const int l = i / 2048, gp = i % 2048, g = gp >> 6, pp = gp & 63;
        unsigned char* W = wt_layer(p, l);
        const float are = p.in[I_S5ARE][l * 2048 + gp], aim = p.in[I_S5AIM][l * 2048 + gp];
        const float lre = fminf(are, -1e-4f), lim = aim;
        const float dt = expf(p.in[I_S5DT][l * 32 + g]);
        const float mag = expf(lre * dt);
        const float lbre = mag * cosf(lim * dt), lbim = mag * sinf(lim * dt);
        const float den = lre * lre + lim * lim;
        const float c1re = ((lbre - 1.0f) * lre + lbim * lim) / den;
        const float c1im = (lbim * lre - (lbre - 1.0f) * lim) / den;
        float* bb = (float*)(W + WO_BBAR) + (size_t)gp * 32;
        const float bre = p.in[I_S5BRE][((size_t)l * 2048 + gp) * 16 + c];
        const float bim = p.in[I_S5BIM][((size_t)l * 2048 + gp) * 16 + c];
        bf16_t* bb2 = (bf16_t*)(W + WO_BB2) + ((size_t)g * 128 + 2 * pp) * 16;
        const float b0 = c1re * bre - c1im * bim, b1 = c1re * bim + c1im * bre;
        bb[c] = b0; bb[16 + c] = b1; bb2[c] = f2bf(b0); bb2[16 + c] = f2bf(b1);
        if (c == 0) {
            float pr = lbre, pi = lbim;
            for (int s_ = 0; s_ < 6; ++s_) { const float nr = pr * pr - pi * pi, ni = 2.f * pr * pi; pr = nr; pi = ni; }
            float* lam = (float*)(W + WO_LAM) + (size_t)gp * 4;
            lam[0] = lbre; lam[1] = lbim; lam[2] = pr; lam[3] = pi;
        }
        bf16_t* cm = (bf16_t*)(W + WO_CMAT) + (size_t)g * 16 * 128;
        const float* cre = p.in[I_S5CRE] + ((size_t)l * 32 + g) * 16 * 64;
        const float* cim = p.in[I_S5CIM] + ((size_t)l * 32 + g) * 16 * 64;
        cm[c * 128 + 2 * pp] = f2bf(cre[c * 64 + pp]); cm[c * 128 + 2 * pp + 1] = f2bf(-cim[c * 64 + pp]);
    }
}

__device__ __forceinline__ u32x4 q16(const float* f, float ia) {
    u32x4 w;
#pragma unroll
    for (int j = 0; j < 4; ++j) {
        const int q0 = (int)rintf(f[4 * j] * ia), q1 = (int)rintf(f[4 * j + 1] * ia), q2 = (int)rintf(f[4 * j + 2] * ia), q3 = (int)rintf(f[4 * j + 3] * ia);
        w[j] = (unsigned)(q0 & 255) | ((unsigned)(q1 & 255) << 8) | ((unsigned)(q2 & 255) << 16) | ((unsigned)(q3 & 255) << 24);
    }
    return w;
}
__device__ void p0b_quant_weights(const Params& p) {
    const int tid = tid_opaque(), lane = tid & 63, wave = tid >> 6, G = gridDim.x, bid = bid_opaque();
#pragma unroll 1
    for (int r0 = bid * 8 + wave; r0 < NL * SW_TOTAL; r0 += G * 32) {
        u32x4 av[4], bv[4]; size_t o8[4]; int ii[4], ll[4]; bool ok[4];
#pragma unroll
        for (int u = 0; u < 4; ++u) {
            const int r = r0 + u * G * 8;
            const int l = r / SW_TOTAL, i = r % SW_TOTAL;
            ok[u] = r < NL * SW_TOTAL && !(i >= SW_WOUT && i < SW_WQ);
            size_t off = WO_WIN, off8 = W8_WIN; int rr = i;
            if (i < SW_WOUT) { off = WO_WIN; off8 = W8_WIN; rr = i; } else if (i < SW_WO) { off = WO_WQ; off8 = W8_WQ; rr = i - SW_WQ; }
            else if (i < SW_WPQ) { off = WO_WO; off8 = W8_WO; rr = i - SW_WO; } else { off = WO_WPQ; off8 = W8_WPQ; rr = i - SW_WPQ; }
            ii[u] = i; ll[u] = l;
            o8[u] = (size_t)l * W8_LAYER + off8 + ((size_t)((rr >> 9) * 16 + (lane >> 2))) * 32768 + (rr & 511) * 64 + (lane & 3) * 16;
            av[u] = (u32x4){0u, 0u, 0u, 0u}; bv[u] = av[u];
            if (ok[u]) { const unsigned char* row = wt_layer(p, l) + off + (size_t)rr * 2048; av[u] = *(const u32x4*)(row + lane * 32); bv[u] = *(const u32x4*)(row + lane * 32 + 16); }
        }
#pragma unroll
        for (int u = 0; u < 4; ++u) {
            if (!ok[u]) continue;
            float f[16]; unpack8(av[u], f); unpack8(bv[u], f + 8);
            float am = 0.f;
#pragma unroll
            for (int j = 0; j < 16; ++j) am = fmaxf(am, fabsf(f[j]));
            am = wave_max(am);
            const u32x4 w = q16(f, am > 0.f ? 127.0f / am : 0.f);
            *(u32x4*)(p.ws + WS_W8 + o8[u]) = w;
            if (lane == 0) ((float*)(wt_layer(p, ll[u]) + WO_SW))[ii[u]] = am * (1.0f / 127.0f);
        }
    }
}

#define TILE_ROWS(rr) for (int rr = wave; rr < 128; rr += 8)
#define TILE_ROWS4(r0) for (int r0 = wave; r0 < 128; r0 += 32)
__device__ __forceinline__ f32x4 tile4(ldsp lds, int rr, int lane) { return *(LAS f32x4*)(lds + ((size_t)rr * 260 + lane * 4) * 4); }
__device__ __forceinline__ f32x4 tile4i(ldsp lds, int rr, int lane) { const i32x4 v = *(LAS i32x4*)(lds + ((size_t)rr * 260 + lane * 4) * 4); return (f32x4){(float)v[0], (float)v[1], (float)v[2], (float)v[3]}; }
__device__ __forceinline__ void st_bf4(bf16_t* d, float a, float b, float c, float e) { uint2 o; o.x = pack2(a, b); o.y = pack2(c, e); *(uint2*)d = o; }

template <class RS>
__device__ __forceinline__ void z_rowpass(ldsp lds, bf16_t* z, RS rowscale, const float* sw, int row0, int col0, int nvalid, int lane, int wave) {
    const float4 w4 = *(const float4*)(sw + col0 + lane * 4);
    const int col = col0 + lane * 4;
    TILE_ROWS4(r0) {
        f32x4 v[4]; float r[4];
#pragma unroll
        for (int u = 0; u < 4; ++u) { v[u] = tile4i(lds, r0 + 8 * u, lane); r[u] = rowscale(r0 + 8 * u); }
        __builtin_amdgcn_sched_group_barrier(0x100, 12, 0);
#pragma unroll
        for (int u = 0; u < 4; ++u)
            if (col < nvalid) st_bf4(z + (size_t)(row0 + r0 + 8 * u) * ZC + col, v[u][0] * r[u] * w4.x, v[u][1] * r[u] * w4.y, v[u][2] * r[u] * w4.z, v[u][3] * r[u] * w4.w);
    }
}

__device__ void phase_a(const Params& p, int l, bool with_kv, ldsp lds) {
    const int G = gridDim.x, bid = bid_opaque();
    const int nz = 256 * 5;
    const int total = nz + (with_kv ? NL * 64 : 0);
    const unsigned char* xq = p.ws + WS_XQ;
    const bool kvfirst = with_kv && G == 256;
#pragma unroll 1
    for (int sq = 0; ; ++sq) {
        int u;
        if (kvfirst) { if (sq == 0) { u = bid + nz; if (u >= total) continue; } else { u = bid + (sq - 1) * G; if (u >= nz) break; } }
        else { u = bid + sq * G; if (u >= total) break; }
        int tid = threadIdx.x;
        asm volatile("" : "+v"(tid));
        const int lane = tid & 63, wave = __builtin_amdgcn_readfirstlane(tid >> 6);
        if (u < nz) {
            const int rt = u & 255, ct = u >> 8;
            if (G == 256 && ct == 0) {
                const float* xin = p.in[I_X] + (size_t)rt * 128 * DM;
                unsigned char* xqt = p.ws + WS_XQ + (size_t)rt * 128 * 1024;
                float* rsw = (float*)(p.ws + WS_RS) + rt * 128; float* sxw = (float*)(p.ws + WS_SX) + rt * 128;
                TILE_ROWS4(r0) {
                    float4 xv[4][4];
#pragma unroll
                    for (int q4 = 0; q4 < 4; ++q4)
#pragma unroll
                        for (int j = 0; j < 4; ++j) xv[q4][j] = ((const float4*)(xin + (size_t)(r0 + 8 * q4) * DM + lane * 16))[j];
#pragma unroll
                    for (int q4 = 0; q4 < 4; ++q4) {
                        const int rr = r0 + 8 * q4;
                        float f[16];
#pragma unroll
                        for (int j = 0; j < 4; ++j) { f[4 * j] = xv[q4][j].x; f[4 * j + 1] = xv[q4][j].y; f[4 * j + 2] = xv[q4][j].z; f[4 * j + 3] = xv[q4][j].w; }
                        float am = 0.f, ss = 0.f;
#pragma unroll
                        for (int j = 0; j < 16; ++j) { am = fmaxf(am, fabsf(f[j])); ss += f[j] * f[j]; }
                        am = wave_max(am); ss = wave_sum(ss);
                        *(u32x4*)(xqt + (size_t)rr * 1024 + lane * 16) = q16(f, am > 0.f ? 127.0f / am : 0.f);
                        if (lane == 0) { rsw[rr] = __builtin_amdgcn_rsqf(ss * (1.0f / DM) + RMS_EPS); sxw[rr] = am * (1.0f / 127.0f); }
                    }
                }
                block_gsync();
            }
            const int nvalid = (l == 0) ? ZN0 : ZN1;
            const float* rsg = (const float*)(p.ws + WS_RS) + rt * 128; const float* sxg = (const float*)(p.ws + WS_SX) + rt * 128;
            const float* sw = (const float*)(wt_layer(p, l) + WO_SW) + SW_WIN;
            i32x16 acc5[2][4];
            gemm512_acc<true>(xq + (size_t)rt * 128 * 1024, 1024, p.ws + WS_W8 + (size_t)l * W8_LAYER + W8_WIN + (size_t)ct * 524288, 64, 32768, 1024, lds, acc5);
#pragma unroll 1
            for (int h = 0; h < 2; ++h) {
                gemm512_store_half(acc5, h, lds);
                z_rowpass(lds, (bf16_t*)(p.ws + WS_Z), [&](int rr) { return rsg[rr] * sxg[rr]; }, sw, rt * 128, ct * 512 + h * 256, nvalid, lane, wave);
                __syncthreads();
            }
        } else {
            const int v = u - nz, ll = v >> 6, w = v & 63, isv = w >> 5, t5 = w & 31, rt = t5 >> 2, ct = t5 & 3;
            const bf16_t* memb = (const bf16_t*)(p.ws + WS_MEMB);
            bf16_t* dst; int bb, hh, r0;
            if (!isv) {
                bb = rt >> 1; hh = ct; r0 = (rt & 1) * 128;
                dst = (bf16_t*)(p.ws + WS_KMEM) + (size_t)ll * 1024 * 1024;
                gemm_to_lds<256>(memb + (size_t)rt * 128 * DM, DM, (const bf16_t*)(wt_layer(p, ll) + WO_WK) + (size_t)ct * 256 * DM, DM, DM, lds);
            } else {
                bb = ct; hh = rt >> 1; r0 = (rt & 1) * 128;
                dst = (bf16_t*)(p.ws + WS_VMEMT) + (size_t)ll * 1024 * 1024;
                gemm_to_lds<256>((const bf16_t*)(wt_layer(p, ll) + WO_WV) + (size_t)rt * 128 * DM, DM, memb + (size_t)ct * 256 * DM, DM, DM, lds);
            }
            const int m6 = (lane & 15) * 4, cpos = isv ? ((m6 & 32) | (((m6 >> 2) & 3) << 3) | (((m6 >> 4) & 1) << 2)) : m6;
            TILE_ROWS(rr) { const f32x4 v4 = tile4(lds, rr, lane); st_bf4(dst + ((size_t)(((bb * 4 + hh) * 4 + (lane >> 4)) * 256 + r0 + rr)) * 64 + cpos, v4[0], v4[1], v4[2], v4[3]); }
        }
        __syncthreads();
    }
}

constexpr size_t WS_F1 = WS_SCR;
constexpr size_t WS_ZS = WS_F1 + (size_t)32 * NCH * 4096 * 2;
constexpr size_t WS_SE = WS_ZS + (size_t)32 * NCH * 4096 * 2;
constexpr size_t WS_BETA = WS_SE + (size_t)128 * NCH * 128 * 4;
static_assert(WS_BETA + (size_t)4096 * 64 * 4 <= WS_END, "scratch overflow");
__device__ __forceinline__ bf16_t* q1_ptr(unsigned char* ws, int l, int item) {
    return (bf16_t*)(ws + ((item >= 2048) ? WS_VB : WS_UB) + (size_t)(1 - l) * 16384 * 1024 + (size_t)(item & 2047) * 8192);
}

constexpr int FS = 68;
constexpr int FB = 64 * FS * 4;
constexpr int HB = 64 * 72 * 2;
constexpr int HS = 144;
constexpr int L_R = 0, L_K = FB, L_LD = 2 * FB, L_AS = 3 * FB, L_V = 4 * FB;
constexpr int L_H = 5 * FB;
#define HSLOT(i) (L_H + (i) * HB)
#define GSLOT(i) ((i) * HB)
constexpr int L_BETA = L_H + 7 * HB, L_PC = L_BETA + 256, L_PART = L_PC + 256;
constexpr int L_CST = L_PART + 2048;
constexpr int L_YF = GSLOT(2);
constexpr int L_GF = HSLOT(3);

template <int KS>
__device__ __forceinline__ f32x16 mm32(ldsp A, int lda, ldsp B, int ldb, int mi, int ni, int lane, f32x16 acc) {
    const int fr = lane & 31, fh = lane >> 5;
#pragma unroll
    for (int k0 = 0; k0 < KS; k0 += 4) {
        constexpr int NK = KS < 4 ? KS : 4;
        bf16x8 a[NK], b[NK];
#pragma unroll
        for (int kk = 0; kk < NK; ++kk) {
            a[kk] = *(LAS bf16x8*)(A + (mi * 32 + fr) * lda + ((k0 + kk) * 16 + fh * 8) * 2);
            b[kk] = *(LAS bf16x8*)(B + (ni * 32 + fr) * ldb + ((k0 + kk) * 16 + fh * 8) * 2);
        }
        __builtin_amdgcn_sched_group_barrier(0x100, 2 * NK, 0);
#pragma unroll
        for (int kk = 0; kk < NK; ++kk) acc = __builtin_amdgcn_mfma_f32_32x32x16_bf16(a[kk], b[kk], acc, 0, 0, 0);
        __builtin_amdgcn_sched_group_barrier(0x008, NK, 0);
    }
    return acc;
}
__device__ __forceinline__ f32x16 zero16() { f32x16 a; for (int r = 0; r < 16; ++r) a[r] = 0.f; return a; }
#define ACCROW(mi, r, fh) ((mi) * 32 + ((r) & 3) + 8 * ((r) >> 2) + 4 * (fh))
__device__ __forceinline__ void hst4(ldsp buf, int stride, int row, int col, float a, float b, float c, float d) { using u2 = __attribute__((ext_vector_type(2))) unsigned; u2 o; o[0] = pack2(a, b); o[1] = pack2(c, d); *(LAS u2*)(buf + row * stride + col * 2) = o; }
__device__ __forceinline__ f32x4 hld4(ldsp buf, int stride, int row, int col) { using u2 = __attribute__((ext_vector_type(2))) unsigned; const u2 w = *(LAS u2*)(buf + row * stride + col * 2); return (f32x4){bflo(w[0]), bfhi(w[0]), bflo(w[1]), bfhi(w[1])}; }
#define ACCBASE(mi, g, fh) ((mi) * 32 + 8 * (g) + 4 * (fh))
__device__ __forceinline__ void hst(ldsp buf, int row, int col, float v) { *(LAS bf16_t*)(buf + row * HS + col * 2) = f2bf(v); }
__device__ __forceinline__ float hld(ldsp buf, int row, int col) { return bf2f(*(LAS bf16_t*)(buf + row * HS + col * 2)); }

__device__ void p0_fold_pq(const Params& p, ldsp lds) {
    const int tid = tid_opaque(), lane = tid & 63, wave = tid >> 6, G = gridDim.x, bid = bid_opaque();
    constexpr int KA = 0, WB = 34816;
#pragma unroll 1
    for (int u = bid; u < NL * 64; u += G) {
        const int l = u >> 6, hc = (u >> 2) & 15, nt = u & 3;
        const float* kf = p.in[I_PKEYS] + ((size_t)(l * 16 + hc) * 128) * 128;
        const float* wf = p.in[I_PWQ] + (size_t)l * 1024 * 2048 + (size_t)(nt * 256) * 2048 + hc * 128;
        const float* gn = p.in[I_NFFN] + l * 1024 + nt * 256;
#pragma unroll
        for (int i = 0; i < 8; ++i) {
            const int e = tid + 512 * i, r = e >> 5, c4 = e & 31;
            const float4 v = *(const float4*)(kf + (size_t)r * 128 + c4 * 4);
            using u2 = __attribute__((ext_vector_type(2))) unsigned;
            u2 o; o[0] = pack2(v.x, v.y); o[1] = pack2(v.z, v.w);
            *(LAS u2*)(lds + KA + r * 272 + c4 * 8) = o;
        }
#pragma unroll
        for (int i = 0; i < 16; ++i) {
            const int e = tid + 512 * i, r = e >> 5, c4 = e & 31;
            const float4 v = *(const float4*)(wf + (size_t)r * 2048 + c4 * 4);
            const float g = gn[r];
            using u2 = __attribute__((ext_vector_type(2))) unsigned;
            u2 o; o[0] = pack2(v.x * g, v.y * g); o[1] = pack2(v.z * g, v.w * g);
            *(LAS u2*)(lds + WB + r * 272 + c4 * 8) = o;
        }
        __syncthreads();
        {
            const int wm = wave & 3, wn = wave >> 2, fr = lane & 31, fh = lane >> 5;
            bf16_t* dst = (bf16_t*)(wt_layer(p, l) + WO_WPQ);
#pragma unroll
            for (int mi = 0; mi < 2; ++mi)
#pragma unroll
                for (int ni = 0; ni < 2; ++ni) {
                    const f32x16 acc = mm32<8>(lds + WB + (wm * 64) * 272, 272, lds + KA + (wn * 64) * 272, 272, mi, ni, lane, zero16());
                    const int key = wn * 64 + ni * 32 + fr;
#pragma unroll
                    for (int g = 0; g < 4; ++g) {
                        uint2 o; o.x = pack2(acc[4 * g], acc[4 * g + 1]); o.y = pack2(acc[4 * g + 2], acc[4 * g + 3]);
                        *(uint2*)(dst + (size_t)(hc * 128 + key) * 1024 + nt * 256 + wm * 64 + ACCBASE(mi, g, fh)) = o;
                    }
                }
        }
        __syncthreads();
    }
}

struct ZPre { u32x4 cw[5], pw[5]; u32x4 hv; uint2 vf[4]; };
struct HeadW { u32x4 w2, a2, v2, g2[4]; };
constexpr int C_W0 = 0, C_A0 = 64, C_KK = 128, C_KA = 192, C_RK = 256, C_V0 = 320, C_LNG = 384, C_LNB = 448, C_MU = 512, C_MUG = 832;
__device__ __forceinline__ void zpre_load(const unsigned char* ws, int item, int tid, ZPre& zp_, int l) {
    const int bh = item & 31, c = item >> 5, b = bh >> 3, h = bh & 7, pt = tid >> 3, pq = tid & 7;
    const bf16_t* zc = (const bf16_t*)(ws + WS_Z) + ((size_t)b * SEQ + (size_t)c * 64 + pt) * ZC + pq * 8;
    const bool hasprev = !(c == 0 && pt == 0);
    const int cols[5] = {h * 64, 512 + h * 64, 1024 + h * 64, 1536, 1600};
#pragma unroll
    for (int i = 0; i < 5; ++i) {
        zp_.cw[i] = *(const u32x4*)(zc + cols[i]);
        zp_.pw[i] = (u32x4){0u, 0u, 0u, 0u};
        if (hasprev) zp_.pw[i] = *(const u32x4*)(zc - ZC + cols[i]);
    }
    zp_.hv = (u32x4){0u, 0u, 0u, 0u};
#pragma unroll
    for (int g = 0; g < 4; ++g) zp_.vf[g] = make_uint2(0u, 0u);
    if (l == 1) {
        if (pq < 4) zp_.hv = *(const u32x4*)(zc + 2304);
        const int wave = tid >> 6, lane = tid & 63;
        if (wave < 4) {
            const int mi = wave >> 1, ni = wave & 1, fr = lane & 31, fh = lane >> 5, t = ni * 32 + fr;
            const bf16_t* vfirst = (const bf16_t*)(ws + WS_VFIRST);
#pragma unroll
            for (int g = 0; g < 4; ++g) zp_.vf[g] = *(const uint2*)(vfirst + ((size_t)b * SEQ + (size_t)c * 64 + t) * 512 + h * 64 + (mi * 32 + 8 * g + 4 * fh));
        }
    }
}
__device__ __forceinline__ void head_consts_load(const Params& p, int l, int h, int tid, ldsp lds, HeadW& hw, int mode) {
    unsigned char* W = p.ws + WS_WT + (size_t)l * WT_LAYER;
    const int pt = tid >> 3, pq = tid & 7;
    hw.w2 = *(const u32x4*)((const bf16_t*)(W + WO_W2T) + h * 4096 + pt * 64 + pq * 8);
    hw.a2 = *(const u32x4*)((const bf16_t*)(W + WO_A2T) + h * 4096 + pt * 64 + pq * 8);
    hw.v2 = (u32x4){0u, 0u, 0u, 0u};
    if (pq < 4) hw.v2 = *(const u32x4*)((const bf16_t*)(W + WO_V2T) + h * 2048 + pt * 32 + pq * 8);
#pragma unroll
    for (int i = 0; i < 4; ++i) { hw.g2[i] = (u32x4){0u, 0u, 0u, 0u}; if (mode == 1 && i < 2) hw.g2[i] = *(const u32x4*)((const bf16_t*)(W + WO_G2T) + h * 8192 + (tid + 512 * i) * 8); }
    const float* mu = p.in[I_MU] + l * 1792;
    LAS float* CST = (LAS float*)(lds + L_CST);
    for (int e = tid; e < 960; e += NTHREADS) {
        const int sg = e >> 6, j = e & 63;
        const float* src;
        if (sg == 0) src = p.in[I_W0] + l * 512 + h * 64;
        else if (sg == 1) src = p.in[I_A0] + l * 512 + h * 64;
        else if (sg == 2) src = p.in[I_KK] + l * 512 + h * 64;
        else if (sg == 3) src = p.in[I_KA] + l * 512 + h * 64;
        else if (sg == 4) src = p.in[I_RK] + l * 512 + h * 64;
        else if (sg == 5) src = p.in[I_V0] + h * 64;
        else if (sg == 6) src = p.in[I_LNG] + l * 512 + h * 64;
        else if (sg == 7) src = p.in[I_LNB] + l * 512 + h * 64;
        else if (sg <= 10) src = mu + (sg - 8) * 512 + h * 64;
        else if (sg == 11) src = mu + 1536;
        else if (sg == 12) src = mu + 1600;
        else src = mu + 1664 + (sg - 13) * 64;
        CST[e] = src[j];
    }
    __syncthreads();
}
__device__ void rwkv_chunk(const Params& p, int l, int item, int mode, ldsp lds, const ZPre& zcur, ZPre& znext, int item_next, const HeadW& hw) {
    int tid = threadIdx.x;
    asm volatile("" : "+v"(tid));
    const int lane = tid & 63, wave = __builtin_amdgcn_readfirstlane(tid >> 6);
    unsigned char* wsl = ptr_opaque(p.ws);
    const int bh = item & 31, c = item >> 5;
    const int b = bh >> 3, h = bh & 7;
    const bf16_t* z = (const bf16_t*)(wsl + WS_Z);
    bf16_t* ymix = (bf16_t*)(wsl + WS_YMIX);
    bf16_t* vfirst = (bf16_t*)(wsl + WS_VFIRST);
    LAS float* CST = (LAS float*)(lds + L_CST);
    LAS float* R = (LAS float*)(lds + L_R); LAS float* KA = (LAS float*)(lds + L_K); LAS float* LD = (LAS float*)(lds + L_LD);
    LAS float* AS = (LAS float*)(lds + L_AS); LAS float* V = (LAS float*)(lds + L_V);
    LAS float* BETA = (LAS float*)(lds + L_BETA); LAS float* PC = (LAS float*)(lds + L_PC); LAS float* PART = (LAS float*)(lds + L_PART);
    const size_t g0 = (size_t)b * SEQ + (size_t)c * 64;
    const int pt = tid >> 3, pq = tid & 7;
    const bool hasprev = !(c == 0 && pt == 0);
    const bf16_t* zc = z + (g0 + pt) * ZC;
    const bf16_t* zp = zc - ZC;
    if (item_next >= 0) zpre_load(wsl, item_next, tid, znext, l);
    auto seg = [&](int si, int col0, float* o) {
        float cf[8], pf[8]; unpack8(zcur.cw[si], cf); unpack8(zcur.pw[si], pf);
        const f32x4 m0 = *(LAS f32x4*)(CST + C_MU + si * 64 + pq * 8), m1 = *(LAS f32x4*)(CST + C_MU + si * 64 + pq * 8 + 4);
        const float mm[8] = {m0[0], m0[1], m0[2], m0[3], m1[0], m1[1], m1[2], m1[3]};
#pragma unroll
        for (int i = 0; i < 8; ++i) o[i] = cf[i] + (pf[i] - cf[i]) * mm[i];
    };
    u32x4 s0pref = {0u, 0u, 0u, 0u};
    if (mode == 1) s0pref = *(const u32x4*)((const bf16_t*)(wsl + WS_ZS) + (size_t)(bh * NCH + c) * 4096 + tid * 8);
    {
        float f[8];
        seg(0, h * 64, f);
        *(LAS f32x4*)(R + pt * FS + pq * 8) = (f32x4){f[0], f[1], f[2], f[3]}; *(LAS f32x4*)(R + pt * FS + pq * 8 + 4) = (f32x4){f[4], f[5], f[6], f[7]};
        seg(1, 512 + h * 64, f);
        *(LAS f32x4*)(KA + pt * FS + pq * 8) = (f32x4){f[0], f[1], f[2], f[3]}; *(LAS f32x4*)(KA + pt * FS + pq * 8 + 4) = (f32x4){f[4], f[5], f[6], f[7]};
        seg(2, 1024 + h * 64, f);
        *(LAS f32x4*)(V + pt * FS + pq * 8) = (f32x4){f[0], f[1], f[2], f[3]}; *(LAS f32x4*)(V + pt * FS + pq * 8 + 4) = (f32x4){f[4], f[5], f[6], f[7]};
        if (l == 0 && mode == 0) {
            u32x4 o; o[0] = pack2(f[0], f[1]); o[1] = pack2(f[2], f[3]); o[2] = pack2(f[4], f[5]); o[3] = pack2(f[6], f[7]);
            *(u32x4*)(vfirst + (g0 + pt) * 512 + h * 64 + pq * 8) = o;
        }
        seg(3, 1536, f);
        { u32x4 o; o[0] = pack2(tanh_(f[0]), tanh_(f[1])); o[1] = pack2(tanh_(f[2]), tanh_(f[3])); o[2] = pack2(tanh_(f[4]), tanh_(f[5])); o[3] = pack2(tanh_(f[6]), tanh_(f[7]));
          *(LAS u32x4*)(lds + HSLOT(0) + pt * HS + pq * 16) = o; }
        *(LAS u32x4*)(lds + HSLOT(2) + pt * HS + pq * 16) = hw.w2;
        seg(4, 1600, f);
        { u32x4 o; o[0] = pack2(f[0], f[1]); o[1] = pack2(f[2], f[3]); o[2] = pack2(f[4], f[5]); o[3] = pack2(f[6], f[7]);
          *(LAS u32x4*)(lds + HSLOT(1) + pt * HS + pq * 16) = o; }
        *(LAS u32x4*)(lds + HSLOT(3) + pt * HS + pq * 16) = hw.a2;
        if (l == 1 && pq < 4) {
            *(LAS u32x4*)(lds + HSLOT(4) + pt * 80 + pq * 16) = zcur.hv;
            *(LAS u32x4*)(lds + HSLOT(5) + pt * 80 + pq * 16) = hw.v2;
        }
    }
    __syncthreads();
    {
        const int w4 = wave & 3, mi = w4 >> 1, ni = w4 & 1, fr = lane & 31, fh = lane >> 5;
        const int t = ni * 32 + fr;
        if (wave < 4) {
            const f32x16 acc = mm32<4>(lds + HSLOT(2), HS, lds + HSLOT(0), HS, mi, ni, lane, zero16());
#pragma unroll
            for (int g = 0; g < 4; ++g) {
                const int n = ACCBASE(mi, g, fh);
                const f32x4 wq = *(LAS f32x4*)(CST + C_W0 + n); const float4 wv = make_float4(wq[0], wq[1], wq[2], wq[3]);
                f32x4 o;
                { float w = wv.x + acc[4 * g];     w = -softplus_(-w) - 0.5f; o[0] = -__expf(w); }
                { float w = wv.y + acc[4 * g + 1]; w = -softplus_(-w) - 0.5f; o[1] = -__expf(w); }
                { float w = wv.z + acc[4 * g + 2]; w = -softplus_(-w) - 0.5f; o[2] = -__expf(w); }
                { float w = wv.w + acc[4 * g + 3]; w = -softplus_(-w) - 0.5f; o[3] = -__expf(w); }
                *(LAS f32x4*)(LD + t * FS + n) = o;
            }
        } else {
            const f32x16 acc = mm32<4>(lds + HSLOT(3), HS, lds + HSLOT(1), HS, mi, ni, lane, zero16());
#pragma unroll
            for (int g = 0; g < 4; ++g) {
                const int n = ACCBASE(mi, g, fh);
                const f32x4 aq = *(LAS f32x4*)(CST + C_A0 + n); const float4 av = make_float4(aq[0], aq[1], aq[2], aq[3]);
                *(LAS f32x4*)(AS + t * FS + n) = (f32x4){sigmoidf_(av.x + acc[4 * g]), sigmoidf_(av.y + acc[4 * g + 1]), sigmoidf_(av.z + acc[4 * g + 2]), sigmoidf_(av.w + acc[4 * g + 3])};
            }
        }
    }
    __syncthreads();
    if (l == 1) {
        if (wave < 4) {
            const int mi = wave >> 1, ni = wave & 1, fr = lane & 31, fh = lane >> 5;
            const int t = ni * 32 + fr;
            const f32x16 acc = mm32<2>(lds + HSLOT(5), 80, lds + HSLOT(4), 80, mi, ni, lane, zero16());
#pragma unroll
            for (int g = 0; g < 4; ++g) {
                const int n = ACCBASE(mi, g, fh);
                const f32x4 vq = *(LAS f32x4*)(CST + C_V0 + n); const float4 vv0 = make_float4(vq[0], vq[1], vq[2], vq[3]);
                const uint2 vfw = zcur.vf[g];
                f32x4 vv = *(LAS f32x4*)(V + t * FS + n);
                vv[0] += (bflo(vfw.x) - vv[0]) * sigmoidf_(vv0.x + acc[4 * g]);
                vv[1] += (bfhi(vfw.x) - vv[1]) * sigmoidf_(vv0.y + acc[4 * g + 1]);
                vv[2] += (bflo(vfw.y) - vv[2]) * sigmoidf_(vv0.z + acc[4 * g + 2]);
                vv[3] += (bfhi(vfw.y) - vv[3]) * sigmoidf_(vv0.w + acc[4 * g + 3]);
                *(LAS f32x4*)(V + t * FS + n) = vv;
                if (mode == 0) { uint2 o; o.x = pack2(vv[0], vv[1]); o.y = pack2(vv[2], vv[3]); *(uint2*)(vfirst + (g0 + t) * 512 + h * 64 + n) = o; }
            }
        }
    }
    {
        const int j = tid & 63, part = tid >> 6;
        float sacc = 0.f;
#pragma unroll
        for (int i = 0; i < 8; ++i) sacc += LD[(part * 8 + i) * FS + j];
        PART[part * 64 + j] = sacc;
        __syncthreads();
        float off = 0.f;
        for (int q = 0; q < part; ++q) off += PART[q * 64 + j];
#pragma unroll
        for (int i = 0; i < 8; ++i) { off += LD[(part * 8 + i) * FS + j]; LD[(part * 8 + i) * FS + j] = off; }
    }
    __syncthreads();
    {
        const int t = pt, q = pq;
        float kv[8], rr[8], av[8], lc[8], lx[8]; float ss = 0.f;
        {
            const f32x4 k0 = *(LAS f32x4*)(KA + t * FS + q * 8), k1 = *(LAS f32x4*)(KA + t * FS + q * 8 + 4);
            const f32x4 r0 = *(LAS f32x4*)(R + t * FS + q * 8), r1 = *(LAS f32x4*)(R + t * FS + q * 8 + 4);
            const f32x4 a0v = *(LAS f32x4*)(AS + t * FS + q * 8), a1v = *(LAS f32x4*)(AS + t * FS + q * 8 + 4);
            const f32x4 c0 = *(LAS f32x4*)(LD + t * FS + q * 8), c1 = *(LAS f32x4*)(LD + t * FS + q * 8 + 4);
            f32x4 x0 = {0.f, 0.f, 0.f, 0.f}, x1 = {0.f, 0.f, 0.f, 0.f};
            if (t > 0) { x0 = *(LAS f32x4*)(LD + (t - 1) * FS + q * 8); x1 = *(LAS f32x4*)(LD + (t - 1) * FS + q * 8 + 4); }
#pragma unroll
            for (int i = 0; i < 4; ++i) { kv[i] = k0[i]; kv[4 + i] = k1[i]; rr[i] = r0[i]; rr[4 + i] = r1[i]; av[i] = a0v[i]; av[4 + i] = a1v[i]; lc[i] = c0[i]; lc[4 + i] = c1[i]; lx[i] = x0[i]; lx[4 + i] = x1[i]; }
        }
        float kk[8];
#pragma unroll
        for (int i = 0; i < 8; ++i) { kk[i] = kv[i] * CST[C_KK + q * 8 + i]; ss += kk[i] * kk[i]; }
        ss = grp8_sum(ss);
        const float inv = fminf(__builtin_amdgcn_rsqf(ss), 1e12f);
        float bs = 0.f;
        float oa[8], orr[8], ob[8], ok[8];
#pragma unroll
        for (int i = 0; i < 8; ++i) {
            const int j = q * 8 + i;
            const float kkn = kk[i] * inv;
            const float kn = kv[i] * (1.0f + (av[i] - 1.0f) * CST[C_KA + j]);
            bs += rr[i] * kn * CST[C_RK + j];
            const float ep = __expf(lc[i]), em = rcp_(ep), ex = __expf(lx[i]);
            oa[i] = -kkn * ex; orr[i] = rr[i] * ep; ob[i] = kkn * av[i] * em; ok[i] = kn * em;
        }
        bs = grp8_sum(bs);
        if (q == 0) { BETA[t] = bs; if (mode == 0) ((float*)(wsl + WS_BETA))[(size_t)item * 64 + t] = bs; }
        if (t == 63) {
#pragma unroll
            for (int i = 0; i < 8; ++i) PC[q * 8 + i] = __expf(lc[i]);
        }
        u32x4 o;
        o[0] = pack2(oa[0], oa[1]); o[1] = pack2(oa[2], oa[3]); o[2] = pack2(oa[4], oa[5]); o[3] = pack2(oa[6], oa[7]);
        *(LAS u32x4*)(lds + HSLOT(0) + t * HS + q * 16) = o;
        o[0] = pack2(orr[0], orr[1]); o[1] = pack2(orr[2], orr[3]); o[2] = pack2(orr[4], orr[5]); o[3] = pack2(orr[6], orr[7]);
        *(LAS u32x4*)(lds + HSLOT(1) + t * HS + q * 16) = o;
        o[0] = pack2(ob[0], ob[1]); o[1] = pack2(ob[2], ob[3]); o[2] = pack2(ob[4], ob[5]); o[3] = pack2(ob[6], ob[7]);
        *(LAS u32x4*)(lds + HSLOT(2) + t * HS + q * 16) = o;
        o[0] = pack2(ok[0], ok[1]); o[1] = pack2(ok[2], ok[3]); o[2] = pack2(ok[4], ok[5]); o[3] = pack2(ok[6], ok[7]);
        *(LAS u32x4*)(lds + HSLOT(3) + t * HS + q * 16) = o;
        const f32x4 v0v = *(LAS f32x4*)(V + t * FS + q * 8), v1v = *(LAS f32x4*)(V + t * FS + q * 8 + 4);
#pragma unroll
        for (int i = 0; i < 8; ++i) {
            const int j = q * 8 + i;
            hst(lds + HSLOT(4), j, t, oa[i]);
            hst(lds + HSLOT(5), j, t, ob[i]);
            hst(lds + HSLOT(6), j, t, i < 4 ? v0v[i] : v1v[i - 4]);
        }
    }
    __syncthreads();
    auto n_tile = [&](int tt) {
        int ln_ = lane; asm volatile("" : "+v"(ln_));
        const int m = tt >> 2, mi = (tt >> 1) & 1, ni = tt & 1, fr = ln_ & 31, fh = ln_ >> 5;
        if (m == 1) {
            const f32x16 acc = mm32<4>(lds + HSLOT(0), HS, lds + HSLOT(3), HS, mi, ni, lane, zero16());
            const int sI = ni * 32 + fr;
#pragma unroll
            for (int g = 0; g < 4; ++g) {
                const int t = ACCBASE(mi, g, fh);
                hst4(lds + GSLOT(2), HS, sI, t, sI < t ? acc[4 * g] : 0.f, sI < t + 1 ? acc[4 * g + 1] : 0.f, sI < t + 2 ? acc[4 * g + 2] : 0.f, sI < t + 3 ? acc[4 * g + 3] : 0.f);
            }
        } else {
            const f32x16 acc = mm32<4>(lds + HSLOT(m == 3 ? 3 : 2), HS, lds + HSLOT(m == 0 ? 0 : 1), HS, mi, ni, lane, zero16());
            const int t = ni * 32 + fr;
#pragma unroll
            for (int g = 0; g < 4; ++g) {
                const int sI = ACCBASE(mi, g, fh);
                float v[4];
#pragma unroll
                for (int e = 0; e < 4; ++e) { const bool keep = (m == 0) ? (sI + e < t) : (sI + e <= t); v[e] = keep ? acc[4 * g + e] : 0.f; }
                if (m == 0) {
                    hst4(lds + GSLOT(0), HS, t, sI, v[0], v[1], v[2], v[3]);
                    hst4(lds + GSLOT(5), HS, t, sI, v[0] + (sI == t ? 1.f : 0.f), v[1] + (sI + 1 == t ? 1.f : 0.f), v[2] + (sI + 2 == t ? 1.f : 0.f), v[3] + (sI + 3 == t ? 1.f : 0.f));
#pragma unroll
                    for (int e = 0; e < 4; ++e) hst(lds + GSLOT(1), sI + e, t, v[e]);
                } else hst4(lds + GSLOT(m == 2 ? 3 : 4), HS, t, sI, v[0], v[1], v[2], v[3]);
            }
        }
    };
    n_tile(wave);
    __syncthreads();
    u32x4 gcw[4], gpw[4];
#pragma unroll
    for (int i = 0; i < 4; ++i) { gcw[i] = (u32x4){0u, 0u, 0u, 0u}; gpw[i] = (u32x4){0u, 0u, 0u, 0u}; }
    if (mode == 1 && wave >= 4) {
#pragma unroll
        for (int i = 0; i < 4; ++i) {
            const int e = tid - 256 + 256 * i, t = e >> 4, q8 = e & 15;
            const bf16_t* zcc = z + (g0 + t) * ZC + 1664 + q8 * 8;
            gcw[i] = *(const u32x4*)zcc;
            if (!(c == 0 && t == 0)) gpw[i] = *(const u32x4*)(zcc - ZC);
        }
    }
#pragma unroll 1
    for (int k = 0; k < 6; ++k) {
        const int Pc = (k & 1) ? GSLOT(6) : GSLOT(0), PcT = (k & 1) ? HSLOT(0) : GSLOT(1);
        const int Pn = (k & 1) ? GSLOT(0) : GSLOT(6), PnT = (k & 1) ? GSLOT(1) : HSLOT(0);
        const int Tp = (k & 1) ? GSLOT(5) : HSLOT(2), Tn = (k & 1) ? HSLOT(2) : GSLOT(5);
        const int w4 = wave & 3, mi = w4 >> 1, ni = w4 & 1, fr = lane & 31, fh = lane >> 5;
        if (wave < 4) {
            if (k < 5) {
                const f32x16 acc = mm32<4>(lds + Pc, HS, lds + PcT, HS, mi, ni, lane, zero16());
                const int j = ni * 32 + fr;
#pragma unroll
                for (int g = 0; g < 4; ++g) {
                    const int i = ACCBASE(mi, g, fh);
                    hst4(lds + PnT, HS, j, i, acc[4 * g], acc[4 * g + 1], acc[4 * g + 2], acc[4 * g + 3]);
#pragma unroll
                    for (int e = 0; e < 4; ++e) hst(lds + Pn, i + e, j, acc[4 * g + e]);
                }
            } else n_tile(12 + wave);
        } else {
            if (k >= 1) {
                const f32x16 acc = mm32<4>(lds + PcT, HS, lds + Tp, HS, mi, ni, lane, zero16());
                const int t = ni * 32 + fr;
#pragma unroll
                for (int g = 0; g < 4; ++g) {
                    const int sI = ACCBASE(mi, g, fh);
                    const f32x4 o = hld4(lds + Tp, HS, t, sI);
                    hst4(lds + Tn, HS, t, sI, acc[4 * g] + o[0], acc[4 * g + 1] + o[1], acc[4 * g + 2] + o[2], acc[4 * g + 3] + o[3]);
                }
            } else n_tile(8 + (wave - 4));
        }
        __syncthreads();
    }
    {
        const int w4 = wave & 3, mi = w4 >> 1, ni = w4 & 1, fr = lane & 31, fh = lane >> 5;
        const f32x16 acc = mm32<4>(lds + HSLOT(2), HS, lds + (wave < 4 ? HSLOT(4) : GSLOT(2)), HS, mi, ni, lane, zero16());
        const int n = ni * 32 + fr;
#pragma unroll
        for (int g = 0; g < 4; ++g) hst4(lds + (wave < 4 ? GSLOT(0) : GSLOT(1)), HS, n, ACCBASE(mi, g, fh), acc[4 * g], acc[4 * g + 1], acc[4 * g + 2], acc[4 * g + 3]);
    }
    __syncthreads();
    if (mode == 0) {
        {
            const int w4 = wave & 3, mi = w4 >> 1, ni = w4 & 1, fr = lane & 31, fh = lane >> 5;
            const f32x16 acc = mm32<4>(lds + (wave < 4 ? GSLOT(0) : GSLOT(1)), HS, lds + GSLOT(3), HS, mi, ni, lane, zero16());
            const int t = ni * 32 + fr;
            bf16_t* Q1g = q1_ptr(wsl, l, item);
#pragma unroll
            for (int g = 0; g < 4; ++g) {
                const int n = ACCBASE(mi, g, fh);
                const f32x4 o = hld4(lds + (wave < 4 ? HSLOT(1) : GSLOT(4)), HS, t, n);
                if (wave < 4) { uint2 w; w.x = pack2(acc[4 * g] + o[0], acc[4 * g + 1] + o[1]); w.y = pack2(acc[4 * g + 2] + o[2], acc[4 * g + 3] + o[3]); *(uint2*)(Q1g + t * 64 + n) = w; }
                else hst4(lds + HSLOT(0), HS, t, n, acc[4 * g] + o[0], acc[4 * g + 1] + o[1], acc[4 * g + 2] + o[2], acc[4 * g + 3] + o[3]);
            }
        }
        {
            const int w4 = wave & 3, mi = w4 >> 1, ni = w4 & 1, fr = lane & 31, fh = lane >> 5;
            const f32x16 acc = mm32<4>(lds + (wave < 4 ? GSLOT(0) : GSLOT(1)), HS, lds + HSLOT(5), HS, mi, ni, lane, zero16());
            const int jo = ni * 32 + fr;
            const float pc = PC[jo];
            if (wave < 4) {
                bf16_t* F1g = (bf16_t*)(wsl + WS_F1) + (size_t)(bh * NCH + c) * 4096;
                const int mt = jo >> 4, row = jo & 15;
#pragma unroll
                for (int g = 0; g < 4; ++g) {
                    const int nb = ACCBASE(mi, g, fh);
                    const int ks = nb >> 5, jj = nb & 31, hi = jj >> 4, qq = (jj & 15) >> 2;
                    uint2 o;
                    o.x = pack2(pc * (acc[4 * g] + (jo == nb ? 1.f : 0.f)), pc * (acc[4 * g + 1] + (jo == nb + 1 ? 1.f : 0.f)));
                    o.y = pack2(pc * (acc[4 * g + 2] + (jo == nb + 2 ? 1.f : 0.f)), pc * (acc[4 * g + 3] + (jo == nb + 3 ? 1.f : 0.f)));
                    *(uint2*)(F1g + (((mt * 2 + ks) * 64 + qq * 16 + row) * 8) + hi * 4) = o;
                }
            } else {
#pragma unroll
                for (int g = 0; g < 4; ++g) {
                    const int sI = ACCBASE(mi, g, fh);
                    hst4(lds + GSLOT(6), HS, jo, sI, pc * (acc[4 * g] + hld(lds + HSLOT(3), sI, jo)), pc * (acc[4 * g + 1] + hld(lds + HSLOT(3), sI + 1, jo)),
                         pc * (acc[4 * g + 2] + hld(lds + HSLOT(3), sI + 2, jo)), pc * (acc[4 * g + 3] + hld(lds + HSLOT(3), sI + 3, jo)));
                }
            }
        }
        __syncthreads();
        if (wave >= 4) {
            const int w4 = wave - 4, mi = w4 >> 1, ni = w4 & 1, fr = lane & 31, fh = lane >> 5;
            const f32x16 acc = mm32<4>(lds + HSLOT(6), HS, lds + HSLOT(0), HS, mi, ni, lane, zero16());
            const int t = ni * 32 + fr;
#pragma unroll
            for (int g = 0; g < 4; ++g) {
                uint2 w; w.x = pack2(acc[4 * g], acc[4 * g + 1]); w.y = pack2(acc[4 * g + 2], acc[4 * g + 3]);
                *(uint2*)(ymix + (g0 + t) * 1024 + h * 64 + ACCBASE(mi, g, fh)) = w;
            }
        }
        if (wave < 4) {
            const int mi = wave >> 1, ni = wave & 1, fr = lane & 31, fh = lane >> 5;
            const f32x16 acc = mm32<4>(lds + GSLOT(6), HS, lds + HSLOT(6), HS, mi, ni, lane, zero16());
            bf16_t* Zg = (bf16_t*)(wsl + WS_ZS) + (size_t)(bh * NCH + c) * 4096;
            const int i = ni * 32 + fr, vg = i >> 4, n = i & 15;
#pragma unroll
            for (int g = 0; g < 4; ++g) {
                const int jb = ACCBASE(mi, g, fh), mt = jb >> 4, qq = (jb & 15) >> 2;
                uint2 o; o.x = pack2(acc[4 * g], acc[4 * g + 1]); o.y = pack2(acc[4 * g + 2], acc[4 * g + 3]);
                *(uint2*)(Zg + (((vg * 4 + mt) * 64 + qq * 16 + n) * 4)) = o;
            }
        }
        __syncthreads();
    } else {
        {
            const int w4 = wave & 3, mi = w4 >> 1, ni = w4 & 1, fr = lane & 31, fh = lane >> 5;
            const f32x16 acc = mm32<4>(lds + (wave < 4 ? GSLOT(0) : GSLOT(1)), HS, lds + GSLOT(3), HS, mi, ni, lane, zero16());
            const int t = ni * 32 + fr;
#pragma unroll
            for (int g = 0; g < 4; ++g) {
                const int n = ACCBASE(mi, g, fh);
                const f32x4 o = hld4(lds + (wave < 4 ? HSLOT(1) : GSLOT(4)), HS, t, n);
                hst4(lds + (wave < 4 ? GSLOT(6) : HSLOT(0)), HS, t, n, acc[4 * g] + o[0], acc[4 * g + 1] + o[1], acc[4 * g + 2] + o[2], acc[4 * g + 3] + o[3]);
            }
            *(LAS u32x4*)(lds + GSLOT(5) + (tid >> 3) * HS + (tid & 7) * 16) = s0pref;
        }
        __syncthreads();
        if (wave < 4) {
            const int mi = wave >> 1, ni = wave & 1, fr = lane & 31, fh = lane >> 5;
            f32x16 acc = mm32<4>(lds + GSLOT(5), HS, lds + GSLOT(6), HS, mi, ni, lane, zero16());
            acc = mm32<4>(lds + HSLOT(6), HS, lds + HSLOT(0), HS, mi, ni, lane, acc);
            LAS float* YF = (LAS float*)(lds + L_YF);
            const int t = ni * 32 + fr;
#pragma unroll
            for (int g = 0; g < 4; ++g) *(LAS f32x4*)(YF + t * FS + ACCBASE(mi, g, fh)) = (f32x4){acc[4 * g], acc[4 * g + 1], acc[4 * g + 2], acc[4 * g + 3]};
        } else {
            const int u = tid - 256;
#pragma unroll
            for (int ii = 0; ii < 4; ++ii) {
                const int e = u + 256 * ii, t = e >> 4, q8 = e & 15;
                float cf[8], pf[8]; unpack8(gcw[ii], cf); unpack8(gpw[ii], pf);
                float g[8];
#pragma unroll
                for (int i = 0; i < 8; ++i) g[i] = sigmoidf_(cf[i] + (pf[i] - cf[i]) * CST[C_MUG + q8 * 8 + i]);
                u32x4 o; o[0] = pack2(g[0], g[1]); o[1] = pack2(g[2], g[3]); o[2] = pack2(g[4], g[5]); o[3] = pack2(g[6], g[7]);
                *(LAS u32x4*)(lds + GSLOT(0) + t * 272 + q8 * 16) = o;
                *(LAS u32x4*)(lds + HSLOT(1) + t * 272 + q8 * 16) = hw.g2[ii];
            }
        }
        __syncthreads();
        if (wave < 4) {
            const int mi = wave >> 1, ni = wave & 1, fr = lane & 31, fh = lane >> 5;
            const f32x16 acc = mm32<8>(lds + HSLOT(1), 272, lds + GSLOT(0), 272, mi, ni, lane, zero16());
            LAS float* GF = (LAS float*)(lds + L_GF);
            const int t = ni * 32 + fr;
#pragma unroll
            for (int g = 0; g < 4; ++g) *(LAS f32x4*)(GF + t * FS + ACCBASE(mi, g, fh)) = (f32x4){acc[4 * g], acc[4 * g + 1], acc[4 * g + 2], acc[4 * g + 3]};
        }
        __syncthreads();
        {
            const int t = pt, q = pq;
            LAS float* YF = (LAS float*)(lds + L_YF); LAS float* GF = (LAS float*)(lds + L_GF);
            float yv[8], gv[8], vv[8]; float sm = 0.f;
            {
                const f32x4 y0 = *(LAS f32x4*)(YF + t * FS + q * 8), y1 = *(LAS f32x4*)(YF + t * FS + q * 8 + 4);
                const f32x4 gg0 = *(LAS f32x4*)(GF + t * FS + q * 8), gg1 = *(LAS f32x4*)(GF + t * FS + q * 8 + 4);
                const f32x4 v0v = *(LAS f32x4*)(V + t * FS + q * 8), v1v = *(LAS f32x4*)(V + t * FS + q * 8 + 4);
#pragma unroll
                for (int i = 0; i < 4; ++i) { yv[i] = y0[i]; yv[4 + i] = y1[i]; gv[i] = gg0[i]; gv[4 + i] = gg1[i]; vv[i] = v0v[i]; vv[4 + i] = v1v[i]; }
            }
#pragma unroll
            for (int i = 0; i < 8; ++i) sm += yv[i];
            sm = grp8_sum(sm);
            const float mean = sm * (1.0f / 64.f);
            float vr = 0.f;
#pragma unroll
            for (int i = 0; i < 8; ++i) { const float d = yv[i] - mean; vr += d * d; }
            vr = grp8_sum(vr);
            const float istd = __builtin_amdgcn_rsqf(vr * (1.0f / 64.f) + GN_EPS);
            const float beta = BETA[t];
            float o[8];
#pragma unroll
            for (int i = 0; i < 8; ++i) { const int j = q * 8 + i; o[i] = ((yv[i] - mean) * istd * CST[C_LNG + j] + CST[C_LNB + j] + beta * vv[i]) * gv[i]; }
            u32x4 ow; ow[0] = pack2(o[0], o[1]); ow[1] = pack2(o[2], o[3]); ow[2] = pack2(o[4], o[5]); ow[3] = pack2(o[6], o[7]);
            *(u32x4*)(ymix + (g0 + t) * 1024 + h * 64 + q * 8) = ow;
        }
        __syncthreads();
    }
}

struct DPre { u32x4 q1, s0, gc[2], gp[2], y2, vv; float beta; };
__device__ __forceinline__ void dpre_load(unsigned char* ws, int l, int item, int tid, DPre& d) {
    const int bh = item & 31, c = item >> 5, b = bh >> 3, h = bh & 7, pt = tid >> 3, pq = tid & 7;
    const size_t g0 = (size_t)b * SEQ + (size_t)c * 64;
    d.q1 = *(const u32x4*)(q1_ptr(ws, l, item) + tid * 8);
    d.s0 = *(const u32x4*)((const bf16_t*)(ws + WS_ZS) + (size_t)(bh * NCH + c) * 4096 + tid * 8);
    const bf16_t* z = (const bf16_t*)(ws + WS_Z);
#pragma unroll
    for (int i = 0; i < 2; ++i) {
        const int e = tid + 512 * i, t = e >> 4, q8 = e & 15;
        const bf16_t* zcc = z + (g0 + t) * ZC + 1664 + q8 * 8;
        d.gc[i] = *(const u32x4*)zcc;
        d.gp[i] = (u32x4){0u, 0u, 0u, 0u};
        if (!(c == 0 && t == 0)) d.gp[i] = *(const u32x4*)(zcc - ZC);
    }
    d.y2 = *(const u32x4*)((const bf16_t*)(ws + WS_YMIX) + (g0 + pt) * 1024 + h * 64 + pq * 8);
    d.vv = *(const u32x4*)((const bf16_t*)(ws + WS_VFIRST) + (g0 + pt) * 512 + h * 64 + pq * 8);
    d.beta = ((const float*)(ws + WS_BETA))[(size_t)item * 64 + pt];
}
__device__ void rwkv_out(const Params& p, int l, int item, ldsp lds, const DPre& dcur, DPre& dnext, int item_next, const HeadW& hw) {
    int tid = threadIdx.x;
    asm volatile("" : "+v"(tid));
    const int lane = tid & 63, wave = __builtin_amdgcn_readfirstlane(tid >> 6);
    unsigned char* wsl = ptr_opaque(p.ws);
    const int bh = item & 31, c = item >> 5, b = bh >> 3, h = bh & 7;
    const size_t g0 = (size_t)b * SEQ + (size_t)c * 64;
    bf16_t* ymix = (bf16_t*)(wsl + WS_YMIX);
    LAS float* CST = (LAS float*)(lds + L_CST);
    if (item_next >= 0) dpre_load(wsl, l, item_next, tid, dnext);
    *(LAS u32x4*)(lds + GSLOT(6) + (tid >> 3) * HS + (tid & 7) * 16) = dcur.q1;
    *(LAS u32x4*)(lds + GSLOT(5) + (tid >> 3) * HS + (tid & 7) * 16) = dcur.s0;
#pragma unroll
    for (int ii = 0; ii < 2; ++ii) {
        const int e = tid + 512 * ii, t = e >> 4, q8 = e & 15;
        float cf[8], pf[8]; unpack8(dcur.gc[ii], cf); unpack8(dcur.gp[ii], pf);
        float g[8];
#pragma unroll
        for (int i = 0; i < 8; ++i) g[i] = sigmoidf_(cf[i] + (pf[i] - cf[i]) * CST[C_MUG + q8 * 8 + i]);
        u32x4 o; o[0] = pack2(g[0], g[1]); o[1] = pack2(g[2], g[3]); o[2] = pack2(g[4], g[5]); o[3] = pack2(g[6], g[7]);
        *(LAS u32x4*)(lds + GSLOT(0) + t * 272 + q8 * 16) = o;
        *(LAS u32x4*)(lds + HSLOT(1) + t * 272 + q8 * 16) = hw.g2[ii];
    }
    __syncthreads();
    {
        const int w4 = wave & 3, mi = w4 >> 1, ni = w4 & 1, fr = lane & 31, fh = lane >> 5;
        const int t = ni * 32 + fr;
        if (wave < 4) {
            const f32x16 acc = mm32<4>(lds + GSLOT(5), HS, lds + GSLOT(6), HS, mi, ni, lane, zero16());
            LAS float* YF = (LAS float*)(lds + L_YF);
#pragma unroll
            for (int g = 0; g < 4; ++g) *(LAS f32x4*)(YF + t * FS + ACCBASE(mi, g, fh)) = (f32x4){acc[4 * g], acc[4 * g + 1], acc[4 * g + 2], acc[4 * g + 3]};
        } else {
            const f32x16 acc = mm32<8>(lds + HSLOT(1), 272, lds + GSLOT(0), 272, mi, ni, lane, zero16());
            LAS float* GF = (LAS float*)(lds + L_GF);
#pragma unroll
            for (int g = 0; g < 4; ++g) *(LAS f32x4*)(GF + t * FS + ACCBASE(mi, g, fh)) = (f32x4){acc[4 * g], acc[4 * g + 1], acc[4 * g + 2], acc[4 * g + 3]};
        }
    }
    __syncthreads();
    {
        const int t = tid >> 3, q = tid & 7;
        LAS float* YF = (LAS float*)(lds + L_YF); LAS float* GF = (LAS float*)(lds + L_GF);
        float yv[8], gv[8], vv[8], y2[8]; float sm = 0.f;
        unpack8(dcur.y2, y2); unpack8(dcur.vv, vv);
        {
            const f32x4 y0 = *(LAS f32x4*)(YF + t * FS + q * 8), y1 = *(LAS f32x4*)(YF + t * FS + q * 8 + 4);
            const f32x4 gg0 = *(LAS f32x4*)(GF + t * FS + q * 8), gg1 = *(LAS f32x4*)(GF + t * FS + q * 8 + 4);
#pragma unroll
            for (int i = 0; i < 4; ++i) { yv[i] = y0[i] + y2[i]; yv[4 + i] = y1[i] + y2[4 + i]; gv[i] = gg0[i]; gv[4 + i] = gg1[i]; }
        }
#pragma unroll
        for (int i = 0; i < 8; ++i) sm += yv[i];
        sm = grp8_sum(sm);
        const float mean = sm * (1.0f / 64.f);
        float vr = 0.f;
#pragma unroll
        for (int i = 0; i < 8; ++i) { const float d = yv[i] - mean; vr += d * d; }
        vr = grp8_sum(vr);
        const float istd = __builtin_amdgcn_rsqf(vr * (1.0f / 64.f) + GN_EPS);
        const float beta = dcur.beta;
        float o[8];
#pragma unroll
        for (int i = 0; i < 8; ++i) { const int j = q * 8 + i; o[i] = ((yv[i] - mean) * istd * CST[C_LNG + j] + CST[C_LNB + j] + beta * vv[i]) * gv[i]; }
        u32x4 ow; ow[0] = pack2(o[0], o[1]); ow[1] = pack2(o[2], o[3]); ow[2] = pack2(o[4], o[5]); ow[3] = pack2(o[6], o[7]);
        *(u32x4*)(ymix + (g0 + t) * 1024 + h * 64 + q * 8) = ow;
    }
    __syncthreads();
}

constexpr int D2_HALF = 36864, D2_S0 = 0, D2_Q1 = 9216, D2_SG = 18432, D2_G2 = 2 * D2_HALF;
struct D2Pre { u32x4 q1[2], s0[2], gc[4], gp[4]; uint2 y2[4], vv[4]; float beta; };
__device__ __forceinline__ void d2pre_load(unsigned char* ws, int l, int item, int tid, D2Pre& d) {
    const int ht = tid & 255, w4 = (tid >> 6) & 3, lane = tid & 63;
    const int bh = item & 31, c = item >> 5, b = bh >> 3, h = bh & 7;
    const size_t g0 = (size_t)b * SEQ + (size_t)c * 64;
#pragma unroll
    for (int i = 0; i < 2; ++i) {
        d.q1[i] = *(const u32x4*)(q1_ptr(ws, l, item) + (ht + 256 * i) * 8);
        d.s0[i] = *(const u32x4*)((const bf16_t*)(ws + WS_ZS) + (size_t)(bh * NCH + c) * 4096 + (ht + 256 * i) * 8);
    }
    const bf16_t* z = (const bf16_t*)(ws + WS_Z);
#pragma unroll
    for (int i = 0; i < 4; ++i) {
        const int e = ht + 256 * i, t = e >> 4, q8 = e & 15;
        const bf16_t* zcc = z + (g0 + t) * ZC + 1664 + q8 * 8;
        d.gc[i] = *(const u32x4*)zcc;
        d.gp[i] = (u32x4){0u, 0u, 0u, 0u};
        if (!(c == 0 && t == 0)) d.gp[i] = *(const u32x4*)(zcc - ZC);
    }
    const int t = w4 * 16 + (lane & 15), q = lane >> 4;
#pragma unroll
    for (int i = 0; i < 4; ++i) {
        d.y2[i] = *(const uint2*)((const bf16_t*)(ws + WS_YMIX) + (g0 + t) * 1024 + h * 64 + 16 * i + 4 * q);
        d.vv[i] = *(const uint2*)((const bf16_t*)(ws + WS_VFIRST) + (g0 + t) * 512 + h * 64 + 16 * i + 4 * q);
    }
    d.beta = ((const float*)(ws + WS_BETA))[(size_t)item * 64 + t];
}
__device__ void rwkv_out2(const Params& p, int l, int item, ldsp lds, const D2Pre& dcur, D2Pre& dnext, int item_next) {
    int tid = threadIdx.x;
    asm volatile("" : "+v"(tid));
    const int lane = tid & 63, ht = tid & 255, w4 = (tid >> 6) & 3, hb = tid >> 8;
    unsigned char* wsl = ptr_opaque(p.ws);
    const int bh = item & 31, c = item >> 5, b = bh >> 3, h = bh & 7;
    const size_t g0 = (size_t)b * SEQ + (size_t)c * 64;
    bf16_t* ymix = (bf16_t*)(wsl + WS_YMIX);
    LAS float* CST = (LAS float*)(lds + L_CST);
    ldsp hbase = lds + hb * D2_HALF;
    if (item_next >= 0) d2pre_load(wsl, l, item_next, tid, dnext);
#pragma unroll
    for (int i = 0; i < 2; ++i) {
        const int e = ht + 256 * i;
        *(LAS u32x4*)(hbase + D2_Q1 + (e >> 3) * HS + (e & 7) * 16) = dcur.q1[i];
        *(LAS u32x4*)(hbase + D2_S0 + (e >> 3) * HS + (e & 7) * 16) = dcur.s0[i];
    }
#pragma unroll
    for (int ii = 0; ii < 4; ++ii) {
        const int e = ht + 256 * ii, t = e >> 4, q8 = e & 15;
        float cf[8], pf[8]; unpack8(dcur.gc[ii], cf); unpack8(dcur.gp[ii], pf);
        float g[8];
#pragma unroll
        for (int i = 0; i < 8; ++i) g[i] = sigmoidf_(cf[i] + (pf[i] - cf[i]) * CST[C_MUG + q8 * 8 + i]);
        u32x4 o; o[0] = pack2(g[0], g[1]); o[1] = pack2(g[2], g[3]); o[2] = pack2(g[4], g[5]); o[3] = pack2(g[6], g[7]);
        *(LAS u32x4*)(hbase + D2_SG + t * 272 + q8 * 16) = o;
    }
    __syncthreads();
    const int c16 = lane & 15, q = lane >> 4, t = w4 * 16 + c16;
    f32x4 ya[4], ga[4];
    {
        bf16x8 bq1[2], aS[8];
#pragma unroll
        for (int ks = 0; ks < 2; ++ks) bq1[ks] = *(LAS bf16x8*)(hbase + D2_Q1 + t * HS + (ks * 32 + q * 8) * 2);
#pragma unroll
        for (int i = 0; i < 4; ++i)
#pragma unroll
            for (int ks = 0; ks < 2; ++ks) aS[i * 2 + ks] = *(LAS bf16x8*)(hbase + D2_S0 + (16 * i + c16) * HS + (ks * 32 + q * 8) * 2);
        __builtin_amdgcn_sched_group_barrier(0x100, 10, 0);
#pragma unroll
        for (int i = 0; i < 4; ++i) {
            f32x4 a = {0.f, 0.f, 0.f, 0.f};
#pragma unroll
            for (int ks = 0; ks < 2; ++ks) a = __builtin_amdgcn_mfma_f32_16x16x32_bf16(aS[i * 2 + ks], bq1[ks], a, 0, 0, 0);
            ya[i] = a;
        }
        __builtin_amdgcn_sched_group_barrier(0x008, 8, 0);
    }
    {
        bf16x8 bsg[4];
#pragma unroll
        for (int ks = 0; ks < 4; ++ks) bsg[ks] = *(LAS bf16x8*)(hbase + D2_SG + t * 272 + (ks * 32 + q * 8) * 2);
#pragma unroll
        for (int i = 0; i < 4; ++i) {
            bf16x8 ag[4];
#pragma unroll
            for (int ks = 0; ks < 4; ++ks) ag[ks] = *(LAS bf16x8*)(lds + D2_G2 + (16 * i + c16) * 272 + (ks * 32 + q * 8) * 2);
            f32x4 a = {0.f, 0.f, 0.f, 0.f};
#pragma unroll
            for (int ks = 0; ks < 4; ++ks) a = __builtin_amdgcn_mfma_f32_16x16x32_bf16(ag[ks], bsg[ks], a, 0, 0, 0);
            ga[i] = a;
        }
    }
    float yv[16]; float sm = 0.f;
#pragma unroll
    for (int i = 0; i < 4; ++i) {
        yv[4 * i] = ya[i][0] + bflo(dcur.y2[i].x); yv[4 * i + 1] = ya[i][1] + bfhi(dcur.y2[i].x); yv[4 * i + 2] = ya[i][2] + bflo(dcur.y2[i].y); yv[4 * i + 3] = ya[i][3] + bfhi(dcur.y2[i].y);
    }
#pragma unroll
    for (int i = 0; i < 16; ++i) sm += yv[i];
    sm += __shfl_xor(sm, 16); sm += __shfl_xor(sm, 32);
    const float mean = sm * (1.0f / 64.f);
    float vr = 0.f;
#pragma unroll
    for (int i = 0; i < 16; ++i) { const float dd = yv[i] - mean; vr += dd * dd; }
    vr += __shfl_xor(vr, 16); vr += __shfl_xor(vr, 32);
    const float istd = __builtin_amdgcn_rsqf(vr * (1.0f / 64.f) + GN_EPS);
    const float beta = dcur.beta;
#pragma unroll
    for (int i = 0; i < 4; ++i) {
        const int ch = 16 * i + 4 * q;
        const f32x4 lg = *(LAS f32x4*)(CST + C_LNG + ch), lb = *(LAS f32x4*)(CST + C_LNB + ch);
        const float v0 = bflo(dcur.vv[i].x), v1 = bfhi(dcur.vv[i].x), v2 = bflo(dcur.vv[i].y), v3 = bfhi(dcur.vv[i].y);
        st_bf4(ymix + (g0 + t) * 1024 + h * 64 + ch,
               ((yv[4 * i] - mean) * istd * lg[0] + lb[0] + beta * v0) * ga[i][0], ((yv[4 * i + 1] - mean) * istd * lg[1] + lb[1] + beta * v1) * ga[i][1],
               ((yv[4 * i + 2] - mean) * istd * lg[2] + lb[2] + beta * v2) * ga[i][2], ((yv[4 * i + 3] - mean) * istd * lg[3] + lb[3] + beta * v3) * ga[i][3]);
    }
    asm volatile("s_waitcnt lgkmcnt(0)" ::: "memory");
    __syncthreads();
}

__device__ void rwkv_scan(const Params& p, int bh, int vg) {
    const int lane = tid_opaque() & 63;
    const bf16_t* F1 = (const bf16_t*)(p.ws + WS_F1) + (size_t)bh * NCH * 4096;
    bf16_t* ZS = (bf16_t*)(p.ws + WS_ZS) + (size_t)bh * NCH * 4096;
    const int n = lane & 15, q = lane >> 4;
    bf16x8 xs[2];
#pragma unroll
    for (int ks = 0; ks < 2; ++ks)
#pragma unroll
        for (int j = 0; j < 8; ++j) xs[ks][j] = 0;
#pragma unroll 1
    for (int c = 0; c < NCH; ++c) {
        bf16x8 af[4][2];
#pragma unroll
        for (int mt = 0; mt < 4; ++mt)
#pragma unroll
            for (int ks = 0; ks < 2; ++ks) af[mt][ks] = *(const bf16x8*)(F1 + (size_t)c * 4096 + ((mt * 2 + ks) * 64 + lane) * 8);
        f32x4 acc[4];
#pragma unroll
        for (int mt = 0; mt < 4; ++mt) {
            const uint2 zw = *(const uint2*)(ZS + (size_t)c * 4096 + ((vg * 4 + mt) * 64 + lane) * 4);
            acc[mt][0] = bflo(zw.x); acc[mt][1] = bfhi(zw.x); acc[mt][2] = bflo(zw.y); acc[mt][3] = bfhi(zw.y);
        }
#pragma unroll
        for (int mt = 0; mt < 4; ++mt)
#pragma unroll
            for (int ks = 0; ks < 2; ++ks) acc[mt] = __builtin_amdgcn_mfma_f32_16x16x32_bf16(af[mt][ks], xs[ks], acc[mt], 0, 0, 0);
#pragma unroll
        for (int ks = 0; ks < 2; ++ks)
#pragma unroll
            for (int hi = 0; hi < 2; ++hi) {
                uint2 o;
                o.x = (unsigned)(unsigned short)xs[ks][hi * 4 + 0] | ((unsigned)(unsigned short)xs[ks][hi * 4 + 1] << 16);
                o.y = (unsigned)(unsigned short)xs[ks][hi * 4 + 2] | ((unsigned)(unsigned short)xs[ks][hi * 4 + 3] << 16);
                *(uint2*)(ZS + (size_t)c * 4096 + (vg * 16 + n) * 64 + ks * 32 + hi * 16 + q * 4) = o;
            }
#pragma unroll
        for (int ks = 0; ks < 2; ++ks)
#pragma unroll
            for (int j = 0; j < 8; ++j) xs[ks][j] = (short)f2bf(acc[ks * 2 + (j >> 2)][j & 3]);
    }
}

__device__ void rwkv_scan_ring(const Params& p, int bh, ldsp lds, bool st) {
    const int tid = tid_opaque(), lane = tid & 63, wave = __builtin_amdgcn_readfirstlane(tid >> 6);
    unsigned char* wsl = ptr_opaque(p.ws);
    const unsigned char* F1 = wsl + WS_F1 + (size_t)bh * NCH * 8192;
    unsigned char* ZS = wsl + WS_ZS + (size_t)bh * NCH * 8192;
    constexpr int D = 6, SLOT = 16384;
    const int lw = wave - 4, vg = wave;
    const int n = lane & 15, q = lane >> 4;
#define SCAN_ISSUE(c_) do { const int sl_ = (c_) & 7; \
        _Pragma("unroll") for (int j = 0; j < 2; ++j) { \
            __builtin_amdgcn_global_load_lds((const unsigned*)(F1 + (size_t)(c_) * 8192 + lw * 2048 + j * 1024 + lane * 16), (LAS unsigned*)(lds + sl_ * SLOT + lw * 2048 + j * 1024), 16, 0, 0); \
            __builtin_amdgcn_global_load_lds((const unsigned*)(ZS + (size_t)(c_) * 8192 + lw * 2048 + j * 1024 + lane * 16), (LAS unsigned*)(lds + sl_ * SLOT + 8192 + lw * 2048 + j * 1024), 16, 0, 0); } } while (0)
    if (wave >= 4) {
#pragma unroll 1
        for (int c = 0; c < D; ++c) SCAN_ISSUE(c);
    }
    bf16x8 xs[2];
#pragma unroll
    for (int ks = 0; ks < 2; ++ks)
#pragma unroll
        for (int j = 0; j < 8; ++j) xs[ks][j] = 0;
#pragma unroll 1
    for (int c = 0; c < NCH; ++c) {
        if (wave >= 4) {
            if (c + D < NCH) { SCAN_ISSUE(c + D); asm volatile("s_waitcnt vmcnt(24)" ::: "memory"); }
            else asm volatile("s_waitcnt vmcnt(0)" ::: "memory");
        }
        asm volatile("s_waitcnt lgkmcnt(0)" ::: "memory");
        __builtin_amdgcn_s_barrier();
        if (wave < 4) {
            ldsp slot = lds + (c & 7) * SLOT;
            f32x4 acc[4];
#pragma unroll
            for (int mt = 0; mt < 4; ++mt) {
                using u32x2 = __attribute__((ext_vector_type(2))) unsigned;
                const u32x2 zw = *(LAS u32x2*)(slot + 8192 + ((vg * 4 + mt) * 64 + lane) * 8);
                acc[mt][0] = bflo(zw[0]); acc[mt][1] = bfhi(zw[0]); acc[mt][2] = bflo(zw[1]); acc[mt][3] = bfhi(zw[1]);
            }
            bf16x8 af[8];
#pragma unroll
            for (int i = 0; i < 8; ++i) af[i] = *(LAS bf16x8*)(slot + (i * 64 + lane) * 16);
            __builtin_amdgcn_sched_group_barrier(0x100, 8, 0);
#pragma unroll
            for (int ks = 0; ks < 2; ++ks)
#pragma unroll
                for (int mt = 0; mt < 4; ++mt) acc[mt] = __builtin_amdgcn_mfma_f32_16x16x32_bf16(af[mt * 2 + ks], xs[ks], acc[mt], 0, 0, 0);
            __builtin_amdgcn_sched_group_barrier(0x008, 8, 0);
#pragma unroll
            for (int ks = 0; ks < 2; ++ks)
#pragma unroll
                for (int hi = 0; hi < 2; ++hi) {
                    uint2 o;
                    o.x = (unsigned)(unsigned short)xs[ks][hi * 4 + 0] | ((unsigned)(unsigned short)xs[ks][hi * 4 + 1] << 16);
                    o.y = (unsigned)(unsigned short)xs[ks][hi * 4 + 2] | ((unsigned)(unsigned short)xs[ks][hi * 4 + 3] << 16);
                    if (st) *(uint2*)((bf16_t*)ZS + (size_t)c * 4096 + (vg * 16 + n) * 64 + ks * 32 + hi * 16 + q * 4) = o;
                }
#pragma unroll
            for (int ks = 0; ks < 2; ++ks)
#pragma unroll
                for (int j = 0; j < 8; ++j) xs[ks][j] = (short)f2bf(acc[ks * 2 + (j >> 2)][j & 3]);
        }
    }
#undef SCAN_ISSUE
}

constexpr int S5_WLDS = 4096 + 3072 + 32 * 272;
struct S5Pre { u32x4 a, b; float2 sv; };
__device__ __forceinline__ void s5_pre(const unsigned char* ws, int wi, int mode, int lane, S5Pre& q) {
    const int bg = wi >> 7, c = wi & 127, b = bg >> 5, g = bg & 31;
    const u32x4* src = (const u32x4*)((const bf16_t*)(ws + WS_Z) + ((size_t)b * SEQ + (size_t)c * 64 + lane) * ZC + 1792 + g * 16);
    q.a = src[0]; q.b = src[1];
    q.sv = make_float2(0.f, 0.f);
    if (mode == 1) q.sv = *((const float2*)(ws + WS_SE) + ((size_t)bg * NCH + c) * 64 + lane);
}
__device__ void s5_chunk(const Params& p, int l, int wi, int mode, ldsp lds, const S5Pre& cur, S5Pre& nxt, int wi_next) {
    int tid = threadIdx.x;
    asm volatile("" : "+v"(tid));
    const int lane = tid & 63, wave = __builtin_amdgcn_readfirstlane(tid >> 6);
    unsigned char* wsl = ptr_opaque(p.ws);
    const int bg = wi >> 7, c = wi & 127;
    const int b = bg >> 5, g = bg & 31;
    unsigned char* W = (wsl + WS_WT + (size_t)(l) * WT_LAYER);
    bf16_t* ymix = (bf16_t*)(wsl + WS_YMIX);
    float2* SE = (float2*)(wsl + WS_SE) + ((size_t)bg * NCH + c) * 64 + lane;
    if (wi_next >= 0) s5_pre(wsl, wi_next, mode, lane, nxt);
    LAS float* U = (LAS float*)(lds + wave * S5_WLDS);
    ldsp Ub = lds + wave * S5_WLDS + 4096;
    ldsp X = lds + wave * S5_WLDS + 4096 + 3072;
    const int fr = lane & 31, fh = lane >> 5;
    bf16x8 bq[4];
    {
        const bf16_t* bb2 = (const bf16_t*)(W + WO_BB2) + ((size_t)g * 128 + fr) * 16 + fh * 8;
#pragma unroll
        for (int mi = 0; mi < 4; ++mi) bq[mi] = *(const bf16x8*)(bb2 + mi * 32 * 16);
    }
    const float4 lam = *(const float4*)((const float*)(W + WO_LAM) + ((size_t)g * 64 + lane) * 4);
    const float lbre = lam.x, lbim = lam.y;
    float xre = cur.sv.x, xim = cur.sv.y;
    const size_t g0 = (size_t)b * SEQ + (size_t)c * 64;
    {
        const u32x4 a = cur.a, bqv = cur.b;
        *(LAS u32x4*)(Ub + lane * 48) = a; *(LAS u32x4*)(Ub + lane * 48 + 16) = bqv;
        if (mode == 1) {
            float f[8];
            unpack8(a, f);
            *(LAS f32x4*)(U + lane * 16) = (f32x4){f[0], f[1], f[2], f[3]}; *(LAS f32x4*)(U + lane * 16 + 4) = (f32x4){f[4], f[5], f[6], f[7]};
            unpack8(bqv, f);
            *(LAS f32x4*)(U + lane * 16 + 8) = (f32x4){f[0], f[1], f[2], f[3]}; *(LAS f32x4*)(U + lane * 16 + 12) = (f32x4){f[4], f[5], f[6], f[7]};
        }
    }
    asm volatile("s_waitcnt lgkmcnt(0)" ::: "memory");
    bf16x8 cf[4];
    float4 dsk4 = make_float4(0.f, 0.f, 0.f, 0.f);
    if (mode == 1) {
        const bf16_t* cm = (const bf16_t*)(W + WO_CMAT) + (size_t)g * 16 * 128 + (lane & 15) * 128 + (lane >> 4) * 8;
#pragma unroll
        for (int kk = 0; kk < 4; ++kk) cf[kk] = *(const bf16x8*)(cm + kk * 32);
        dsk4 = *(const float4*)(p.in[I_S5D] + l * 512 + g * 16 + (lane >> 4) * 4);
    }
#pragma unroll 1
    for (int sub = 0; sub < 2; ++sub) {
        {
            const bf16x8 yf = *(LAS bf16x8*)(Ub + (sub * 32 + fr) * 48 + fh * 16);
            f32x16 accs[4];
#pragma unroll
            for (int mi = 0; mi < 4; ++mi) accs[mi] = __builtin_amdgcn_mfma_f32_32x32x16_bf16(bq[mi], yf, zero16(), 0, 0, 0);
            __builtin_amdgcn_sched_group_barrier(0x008, 4, 0);
#pragma unroll
            for (int mi = 0; mi < 4; ++mi)
#pragma unroll
                for (int gq = 0; gq < 4; ++gq) hst4(X, 272, fr, ACCBASE(mi, gq, fh), accs[mi][4 * gq], accs[mi][4 * gq + 1], accs[mi][4 * gq + 2], accs[mi][4 * gq + 3]);
        }
        asm volatile("s_waitcnt lgkmcnt(0)" ::: "memory");
#pragma unroll 1
        for (int t0 = 0; t0 < 32; t0 += 16) {
            unsigned wv[16];
#pragma unroll
            for (int i = 0; i < 16; ++i) wv[i] = *(LAS unsigned*)(X + (t0 + i) * 272 + lane * 4);
#pragma unroll
            for (int i = 0; i < 16; ++i) {
                const float nr = lbre * xre - lbim * xim + bflo(wv[i]);
                const float ni = lbre * xim + lbim * xre + bfhi(wv[i]);
                xre = nr; xim = ni;
                if (mode == 1) *(LAS unsigned*)(X + (t0 + i) * 272 + lane * 4) = pack2(xre, xim);
            }
        }
        asm volatile("s_waitcnt lgkmcnt(0)" ::: "memory");
        if (mode == 1) {
            bf16x8 xa[2][4];
#pragma unroll
            for (int mi = 0; mi < 2; ++mi)
#pragma unroll
                for (int kk = 0; kk < 4; ++kk) xa[mi][kk] = *(LAS bf16x8*)(X + (mi * 16 + (lane & 15)) * 272 + (kk * 32 + (lane >> 4) * 8) * 2);
            __builtin_amdgcn_sched_group_barrier(0x100, 8, 0);
            f32x4 acc2[2] = {{0.f, 0.f, 0.f, 0.f}, {0.f, 0.f, 0.f, 0.f}};
#pragma unroll
            for (int kk = 0; kk < 4; ++kk)
#pragma unroll
                for (int mi = 0; mi < 2; ++mi) acc2[mi] = __builtin_amdgcn_mfma_f32_16x16x32_bf16(cf[kk], xa[mi][kk], acc2[mi], 0, 0, 0);
            __builtin_amdgcn_sched_group_barrier(0x008, 8, 0);
#pragma unroll
            for (int mi = 0; mi < 2; ++mi) {
                const f32x4 acc = acc2[mi];
                const int t = sub * 32 + mi * 16 + (lane & 15), c4 = (lane >> 4) * 4;
                const f32x4 uu = *(LAS f32x4*)(U + t * 16 + c4);
                st_bf4(ymix + (g0 + t) * 1024 + 512 + g * 16 + c4, gelu_(acc[0] + dsk4.x * uu[0]), gelu_(acc[1] + dsk4.y * uu[1]), gelu_(acc[2] + dsk4.z * uu[2]), gelu_(acc[3] + dsk4.w * uu[3]));
            }
            asm volatile("s_waitcnt lgkmcnt(0)" ::: "memory");
        }
    }
    if (mode == 0) *SE = make_float2(xre, xim);
}

__device__ void phase_bd(const Params& p, int l, int mode, ldsp lds) {
    const int bid = bid_opaque(), G = gridDim.x, wave = tid_opaque() >> 6;
    if (mode == 0) {
        ZPre za, zb;
        HeadW hw;
        int cur_bh = -1;
        zpre_load(p.ws, bid, tid_opaque(), za, l);
#pragma unroll 1
        for (int it = bid; it < 32 * NCH; it += G) {
            if ((it & 31) != cur_bh) { cur_bh = it & 31; __syncthreads(); head_consts_load(p, l, cur_bh & 7, tid_opaque(), lds, hw, 0); }
            rwkv_chunk(p, l, it, 0, lds, za, zb, (it + G < 32 * NCH) ? it + G : -1, hw);
            za = zb;
        }
    } else if ((G & 31) == 0 && ((32 * NCH) % (2 * G)) == 0) {
        D2Pre da, db;
        HeadW hw;
        int cur_bh = -1;
        const int tidq = tid_opaque(), hb = tidq >> 8;
        d2pre_load(p.ws, l, bid + hb * G, tidq, da);
#pragma unroll 1
        for (int it = bid; it < 32 * NCH; it += 2 * G) {
            if ((it & 31) != cur_bh) {
                cur_bh = it & 31; __syncthreads();
                head_consts_load(p, l, cur_bh & 7, tidq, lds, hw, 0);
                const bf16_t* g2T = (const bf16_t*)(wt_layer(p, l) + WO_G2T) + (cur_bh & 7) * 8192;
#pragma unroll
                for (int i = 0; i < 2; ++i) { const int e = tidq + 512 * i; *(LAS u32x4*)(lds + D2_G2 + (e >> 4) * 272 + (e & 15) * 16) = *(const u32x4*)(g2T + e * 8); }
                __syncthreads();
            }
            const int mine = it + hb * G, nxt = mine + 2 * G;
            rwkv_out2(p, l, mine, lds, da, db, nxt < 32 * NCH ? nxt : -1);
            da = db;
        }
    } else {
        DPre da, db;
        HeadW hw;
        int cur_bh = -1;
        dpre_load(p.ws, l, bid, tid_opaque(), da);
#pragma unroll 1
        for (int it = bid; it < 32 * NCH; it += G) {
            if ((it & 31) != cur_bh) { cur_bh = it & 31; __syncthreads(); head_consts_load(p, l, cur_bh & 7, tid_opaque(), lds, hw, 1); }
            rwkv_out(p, l, it, lds, da, db, (it + G < 32 * NCH) ? it + G : -1, hw);
            da = db;
        }
    }
    __syncthreads();
#pragma unroll 1
    for (int s5rep = 0; s5rep < ((PROBE & 8388608) ? 2 : 1); ++s5rep)
    {
        S5Pre qa, qb;
        const int ln_ = tid_opaque() & 63;
        if (bid < 2048) s5_pre(p.ws, bid * 8 + wave, mode, ln_, qa);
#pragma unroll 1
        for (int it = bid; it < 2048; it += G) {
            s5_chunk(p, l, it * 8 + wave, mode, lds, qa, qb, (it + G < 2048) ? (it + G) * 8 + wave : -1);
            qa = qb;
        }
    }
}

__device__ void phase_c(const Params& p, int l, ldsp lds, bool st) {
    const int bid = bid_opaque(), G = gridDim.x, tid = tid_opaque(), wave = tid >> 6;
    if (bid < 32) rwkv_scan_ring(p, bid, lds, st);
    else if (bid < 48) {
        const int idx = (bid - 32) * NTHREADS + tid, bg = idx >> 6, pp = idx & 63, g = bg & 31;
        const float4 lam = *(const float4*)((const float*)(wt_layer(p, l) + WO_LAM) + ((size_t)g * 64 + pp) * 4);
        float2* SE = (float2*)(p.ws + WS_SE) + (size_t)bg * NCH * 64 + pp;
        float cr = 0.f, ci = 0.f;
#pragma unroll 1
        for (int c0 = 0; c0 < NCH; c0 += 16) {
            float2 e[16];
#pragma unroll
            for (int i = 0; i < 16; ++i) e[i] = SE[(c0 + i) * 64];
#pragma unroll
            for (int i = 0; i < 16; ++i) {
                if (st) SE[(c0 + i) * 64] = make_float2(cr, ci);
                const float nr = lam.z * cr - lam.w * ci + e[i].x, ni = lam.z * ci + lam.w * cr + e[i].y;
                cr = nr; ci = ni;
            }
        }
    }
    else convert_tables(p, l, bid - 48, G - 48);
}

#ifndef ESUB
#define ESUB 0xff
#endif
constexpr int L_SSQ = LDS_TOTAL - 2048;
constexpr int L_RSN = LDS_TOTAL - 1536;
constexpr int L_TK = 128 * 132 * 4;

__device__ __forceinline__ int f2key(float f, int payload, int mask) { int u = __float_as_int(f); u = (u & ~mask) | payload; return u ^ ((u >> 31) & 0x7fffffff); }
__device__ __forceinline__ int key2u(int k) { return k ^ ((k >> 31) & 0x7fffffff); }
__device__ __forceinline__ void ce_desc(int& a, int& b) { const int mx = max(a, b), mn = min(a, b); a = mx; b = mn; }
__device__ __forceinline__ void sort16_desc(int* v) {
    ce_desc(v[0], v[13]); ce_desc(v[1], v[12]); ce_desc(v[2], v[15]); ce_desc(v[3], v[14]); ce_desc(v[4], v[8]); ce_desc(v[5], v[6]); ce_desc(v[7], v[11]); ce_desc(v[9], v[10]);
    ce_desc(v[0], v[5]); ce_desc(v[1], v[7]); ce_desc(v[2], v[9]); ce_desc(v[3], v[4]); ce_desc(v[6], v[13]); ce_desc(v[8], v[14]); ce_desc(v[10], v[15]); ce_desc(v[11], v[12]);
    ce_desc(v[0], v[1]); ce_desc(v[2], v[3]); ce_desc(v[4], v[5]); ce_desc(v[6], v[8]); ce_desc(v[7], v[9]); ce_desc(v[10], v[11]); ce_desc(v[12], v[13]); ce_desc(v[14], v[15]);
    ce_desc(v[0], v[2]); ce_desc(v[1], v[3]); ce_desc(v[4], v[10]); ce_desc(v[5], v[11]); ce_desc(v[6], v[7]); ce_desc(v[8], v[9]); ce_desc(v[12], v[14]); ce_desc(v[13], v[15]);
    ce_desc(v[1], v[2]); ce_desc(v[3], v[12]); ce_desc(v[4], v[6]); ce_desc(v[5], v[7]); ce_desc(v[8], v[10]); ce_desc(v[9], v[11]); ce_desc(v[13], v[14]);
    ce_desc(v[1], v[4]); ce_desc(v[2], v[6]); ce_desc(v[5], v[8]); ce_desc(v[7], v[10]); ce_desc(v[9], v[13]); ce_desc(v[11], v[14]);
    ce_desc(v[2], v[4]); ce_desc(v[3], v[6]); ce_desc(v[9], v[12]); ce_desc(v[11], v[13]);
    ce_desc(v[3], v[5]); ce_desc(v[6], v[8]); ce_desc(v[7], v[9]); ce_desc(v[10], v[12]);
    ce_desc(v[3], v[4]); ce_desc(v[5], v[6]); ce_desc(v[7], v[8]); ce_desc(v[9], v[10]); ce_desc(v[11], v[12]);
    ce_desc(v[6], v[7]); ce_desc(v[8], v[9]);
}
__device__ __forceinline__ void merge16_desc(int* A, const int* B) {
#pragma unroll
    for (int i = 0; i < 16; ++i) A[i] = max(A[i], B[15 - i]);
#pragma unroll
    for (int j = 8; j > 0; j >>= 1)
#pragma unroll
        for (int i = 0; i < 16; ++i) if ((i & j) == 0) ce_desc(A[i], A[i | j]);
}

__device__ __forceinline__ void xadd_rowpass_f(ldsp lds, float* x, const float* xsrc, int row0, int col0, int lane, int wave, bool xw = true) {
    TILE_ROWS4(r0) {
        f32x4 v[4]; float4 xv[4];
#pragma unroll
        for (int u = 0; u < 4; ++u) { v[u] = tile4(lds, r0 + 8 * u, lane); xv[u] = *(const float4*)(xsrc + (size_t)(row0 + r0 + 8 * u) * DM + col0 + lane * 4); }
        __builtin_amdgcn_sched_group_barrier(0x100, 4, 0);
#pragma unroll
        for (int u = 0; u < 4; ++u) {
            xv[u].x += v[u][0]; xv[u].y += v[u][1]; xv[u].z += v[u][2]; xv[u].w += v[u][3];
            if (xw) *(float4*)(x + (size_t)(row0 + r0 + 8 * u) * DM + col0 + lane * 4) = xv[u];
        }
    }
}
__device__ __forceinline__ void xadd_rowpass_i(ldsp lds, float* x, const float* sw, int row0, int col0, int lane, int wave, bool xw = true) {
    LAS float* sal = (LAS float*)(lds + L_SAL);
    const float4 w4 = *(const float4*)(sw + col0 + lane * 4);
    TILE_ROWS4(r0) {
        f32x4 v[4]; float sa[4]; float4 xv[4];
#pragma unroll
        for (int u = 0; u < 4; ++u) { v[u] = tile4i(lds, r0 + 8 * u, lane); sa[u] = sal[r0 + 8 * u]; xv[u] = *(const float4*)(x + (size_t)(row0 + r0 + 8 * u) * DM + col0 + lane * 4); }
        __builtin_amdgcn_sched_group_barrier(0x100, 8, 0);
#pragma unroll
        for (int u = 0; u < 4; ++u) {
            xv[u].x += v[u][0] * sa[u] * w4.x; xv[u].y += v[u][1] * sa[u] * w4.y; xv[u].z += v[u][2] * sa[u] * w4.z; xv[u].w += v[u][3] * sa[u] * w4.w;
            if (xw) *(float4*)(x + (size_t)(row0 + r0 + 8 * u) * DM + col0 + lane * 4) = xv[u];
        }
    }
}
__device__ __forceinline__ void quant_rows_bf16(const bf16_t* src, int ld, unsigned char* dst, ldsp lds, int lane, int wave) {
    LAS float* sal = (LAS float*)(lds + L_SAL);
    TILE_ROWS4(r0) {
        u32x4 av[4], bv[4];
#pragma unroll
        for (int u = 0; u < 4; ++u) { av[u] = *(const u32x4*)(src + (size_t)(r0 + 8 * u) * ld + lane * 16); bv[u] = *(const u32x4*)(src + (size_t)(r0 + 8 * u) * ld + lane * 16 + 8); }
#pragma unroll
        for (int u = 0; u < 4; ++u) {
            const int rr = r0 + 8 * u;
            float f[16]; unpack8(av[u], f); unpack8(bv[u], f + 8);
            float am = 0.f;
#pragma unroll
            for (int j = 0; j < 16; ++j) am = fmaxf(am, fabsf(f[j]));
            am = wave_max(am);
            *(u32x4*)(dst + (size_t)rr * 1024 + lane * 16) = q16(f, am > 0.f ? 127.0f / am : 0.f);
            if (lane == 0) sal[rr] = am * (1.0f / 127.0f);
        }
    }
}
__device__ __forceinline__ void quant_rows_x(const float* x, unsigned char* xq, ldsp lds, int lane, int wave) {
    LAS float* sxl = (LAS float*)(lds + L_SXL); LAS float* rsl = (LAS float*)(lds + LDS_RSL);
    TILE_ROWS4(r0) {
        float4 xv[4][4];
#pragma unroll
        for (int u = 0; u < 4; ++u)
#pragma unroll
            for (int j = 0; j < 4; ++j) xv[u][j] = ((const float4*)(x + (size_t)(r0 + 8 * u) * DM + lane * 16))[j];
#pragma unroll
        for (int u = 0; u < 4; ++u) {
            const int rr = r0 + 8 * u;
            float f[16];
#pragma unroll
            for (int j = 0; j < 4; ++j) { f[4 * j] = xv[u][j].x; f[4 * j + 1] = xv[u][j].y; f[4 * j + 2] = xv[u][j].z; f[4 * j + 3] = xv[u][j].w; }
            float am = 0.f, ss = 0.f;
#pragma unroll
            for (int j = 0; j < 16; ++j) { am = fmaxf(am, fabsf(f[j])); ss += f[j] * f[j]; }
            am = wave_max(am); ss = wave_sum(ss);
            *(u32x4*)(xq + (size_t)rr * 1024 + lane * 16) = q16(f, am > 0.f ? 127.0f / am : 0.f);
            if (lane == 0) { sxl[rr] = am * (1.0f / 127.0f); rsl[rr] = __builtin_amdgcn_rsqf(ss * (1.0f / DM) + RMS_EPS); }
        }
    }
}

__device__ __forceinline__ void attn_head(const bf16_t* __restrict__ Q, const bf16_t* __restrict__ Kh, const bf16_t* __restrict__ Vh, bf16_t* __restrict__ O, ldsp lds) {
    int tid = threadIdx.x;
    asm volatile("" : "+v"(tid));
    const int lane = tid & 63, wave = tid >> 6;
    const int wvu = __builtin_amdgcn_readfirstlane(wave);
    const int tg = wave & 3, mh = wave >> 2, fr = lane & 31, fh = lane >> 5;
    const int t = tg * 32 + fr;
    bf16x8 qf[16];
#pragma unroll
    for (int ks = 0; ks < 16; ++ks) qf[ks] = *(const bf16x8*)(Q + (size_t)t * ZC + ks * 16 + fh * 8);
    {
        const int crow = tid >> 3, lslot = (tid & 7) ^ ((crow >> 1) & 7);
        const bf16_t* Kg = Kh + (size_t)crow * 1024 + lslot * 8;
#pragma unroll
        for (int kt = 0; kt < 4; ++kt)
#pragma unroll
            for (int j = 0; j < 4; ++j)
                __builtin_amdgcn_global_load_lds((const unsigned*)(Kg + (size_t)(64 * j) * 1024 + kt * 64), (LAS unsigned*)(lds + kt * 32768 + j * 8192 + wvu * 1024), 16, 0, 0);
    }
    f32x16 S[4];
#pragma unroll
    for (int j = 0; j < 4; ++j)
#pragma unroll
        for (int r = 0; r < 16; ++r) S[j][r] = 0.f;
#pragma unroll
    for (int kt = 0; kt < 4; ++kt) {
        if (kt == 0) asm volatile("s_waitcnt vmcnt(12)" ::: "memory");
        else if (kt == 1) asm volatile("s_waitcnt vmcnt(8)" ::: "memory");
        else if (kt == 2) asm volatile("s_waitcnt vmcnt(4)" ::: "memory");
        else asm volatile("s_waitcnt vmcnt(0)" ::: "memory");
        __builtin_amdgcn_s_barrier();
        ldsp base = lds + kt * 32768;
#pragma unroll
        for (int kk = 0; kk < 4; ++kk) {
            bf16x8 a[4];
#pragma unroll
            for (int j = 0; j < 4; ++j) a[j] = *(LAS bf16x8*)(base + swz(mh * 128 + j * 32 + fr, kk * 2 + fh));
#pragma unroll
            for (int j = 0; j < 4; ++j) S[j] = __builtin_amdgcn_mfma_f32_32x32x16_bf16(a[j], qf[kt * 4 + kk], S[j], 0, 0, 0);
        }
    }
    float mx = -3.0e38f;
#pragma unroll
    for (int j = 0; j < 4; ++j)
#pragma unroll
        for (int r = 0; r < 16; ++r) { S[j][r] *= 0.0625f; mx = fmaxf(mx, S[j][r]); }
    mx = fmaxf(mx, __shfl_xor(mx, 32));
    float sm = 0.f;
#pragma unroll
    for (int j = 0; j < 4; ++j)
#pragma unroll
        for (int r = 0; r < 16; ++r) { S[j][r] = __expf(S[j][r] - mx); sm += S[j][r]; }
    sm += __shfl_xor(sm, 32);
    LAS float* EX = (LAS float*)(lds + 135168);
    if (fh == 0) { EX[(mh * 128 + t) * 2] = mx; EX[(mh * 128 + t) * 2 + 1] = sm; }
    __syncthreads();
    const float mo = EX[((mh ^ 1) * 128 + t) * 2], so = EX[((mh ^ 1) * 128 + t) * 2 + 1];
    const float gm = fmaxf(mx, mo);
    const float fme = __expf(mx - gm), fot = __expf(mo - gm);
    const float fac = fme * rcp_(sm * fme + so * fot);
    const int crow = tid >> 3, lslot = (tid & 7) ^ ((crow >> 1) & 7);
    const bf16_t* Vg = Vh + (size_t)crow * 1024 + lslot * 8;
#define ATT_ISSUE_V(ms_, slot_) _Pragma("unroll") for (int j = 0; j < 4; ++j) \
        __builtin_amdgcn_global_load_lds((const unsigned*)(Vg + (size_t)(64 * j) * 1024 + (ms_) * 64), (LAS unsigned*)(lds + (slot_) * 32768 + j * 8192 + wvu * 1024), 16, 0, 0)
    ATT_ISSUE_V(0, 0);
    ATT_ISSUE_V(1, 1);
    ldsp PX = lds + 65536;
#pragma unroll
    for (int j = 0; j < 4; ++j)
#pragma unroll
        for (int s2 = 0; s2 < 2; ++s2) {
            u32x4 w;
#pragma unroll
            for (int i = 0; i < 4; ++i) w[i] = pack2(S[j][8 * s2 + 2 * i] * fac, S[j][8 * s2 + 2 * i + 1] * fac);
            *(LAS u32x4*)(PX + ((((mh * 4 + j) * 2 + s2) * 4 + tg) * 64 + lane) * 16) = w;
        }
    f32x16 Oa[4];
#pragma unroll
    for (int i = 0; i < 4; ++i)
#pragma unroll
        for (int r = 0; r < 16; ++r) Oa[i][r] = 0.f;
#pragma unroll
    for (int ms = 0; ms < 4; ++ms) {
        if (ms < 3) asm volatile("s_waitcnt vmcnt(4)" ::: "memory"); else asm volatile("s_waitcnt vmcnt(0)" ::: "memory");
        asm volatile("s_waitcnt lgkmcnt(0)" ::: "memory");
        __builtin_amdgcn_s_barrier();
        ldsp base = lds + (ms & 1) * 32768;
#pragma unroll
        for (int kq = 0; kq < 4; ++kq) {
            const int src = (((ms >> 1) * 4 + (ms & 1) * 2 + (kq >> 1)) * 2 + (kq & 1)) * 4 + tg;
            const bf16x8 bfr = *(LAS bf16x8*)(PX + (src * 64 + lane) * 16);
#pragma unroll
            for (int i = 0; i < 4; ++i) {
                const int row = mh * 128 + i * 32 + fr;
                using u32x2 = __attribute__((ext_vector_type(2))) unsigned;
                const u32x2 lo = *(LAS u32x2*)(base + swz(row, 2 * kq) + 8 * fh), hi = *(LAS u32x2*)(base + swz(row, 2 * kq + 1) + 8 * fh);
                const u32x4 av = {lo[0], lo[1], hi[0], hi[1]};
                Oa[i] = __builtin_amdgcn_mfma_f32_32x32x16_bf16(__builtin_bit_cast(bf16x8, av), bfr, Oa[i], 0, 0, 0);
            }
        }
        if (ms < 2) {
            asm volatile("s_waitcnt lgkmcnt(0)" ::: "memory");
            __builtin_amdgcn_s_barrier();
            ATT_ISSUE_V(ms + 2, ms & 1);
        }
    }
#undef ATT_ISSUE_V
#pragma unroll
    for (int i = 0; i < 4; ++i)
#pragma unroll
        for (int g = 0; g < 4; ++g)
            st_bf4(O + (size_t)t * ZC + mh * 128 + i * 32 + 8 * g + 4 * fh, Oa[i][4 * g], Oa[i][4 * g + 1], Oa[i][4 * g + 2], Oa[i][4 * g + 3]);
}

__device__ __forceinline__ void attn_all(const bf16_t* __restrict__ Qz, const bf16_t* __restrict__ Kb, const bf16_t* __restrict__ Vb, bf16_t* __restrict__ Oz, ldsp lds) {
    int tid = threadIdx.x;
    asm volatile("" : "+v"(tid));
    const int lane = tid & 63, wave = tid >> 6;
    const int wvu = __builtin_amdgcn_readfirstlane(wave);
    const int c16 = lane & 15, q = lane >> 4, t = wave * 16 + c16;
    const int crow = tid >> 3, lslot = (tid & 7) ^ ((crow >> 1) & 7);
    const unsigned lbase = __builtin_amdgcn_readfirstlane((unsigned)(size_t)lds + wvu * 1024);
    auto issue = [&](int n) {
        const int h = n >> 3, idx = n & 3;
        const bf16_t* src = (((n >> 2) & 1) ? Vb : Kb) + (size_t)((h * 4 + idx) * 256 + crow) * 64 + lslot * 8;
#pragma unroll
        for (int j = 0; j < 4; ++j)
            dma16_asm(src + (size_t)(64 * j) * 64, lbase + (n & 3) * 32768 + j * 8192);
    };
    issue(0); issue(1); issue(2);
    const int rb = c16 * 128, xs = (c16 >> 1) & 7;
#define ATT_LA 8
#define ATT_SG1() do { __builtin_amdgcn_sched_group_barrier(0x008, 1, 0); __builtin_amdgcn_sched_group_barrier(0x100, 1, 0); } while (0)
#define ATT_SG8() do { ATT_SG1(); ATT_SG1(); ATT_SG1(); ATT_SG1(); ATT_SG1(); ATT_SG1(); ATT_SG1(); ATT_SG1(); } while (0)
#define ATT_SCHED() do { __builtin_amdgcn_sched_group_barrier(0x100, ATT_LA, 0); ATT_SG8(); ATT_SG8(); ATT_SG8(); __builtin_amdgcn_sched_group_barrier(0x008, ATT_LA, 0); } while (0)
#define ATT_TOP(n_, x_) do { const int nn_ = (n_); \
        __builtin_amdgcn_sched_barrier(0); \
        if (x_) { if (nn_ + 2 < 32) asm volatile("s_waitcnt vmcnt(16)" ::: "memory"); else if (nn_ + 1 < 32) asm volatile("s_waitcnt vmcnt(12)" ::: "memory"); else asm volatile("s_waitcnt vmcnt(8)" ::: "memory"); } \
        else if (nn_ + 2 < 32) asm volatile("s_waitcnt vmcnt(8)" ::: "memory"); else if (nn_ + 1 < 32) asm volatile("s_waitcnt vmcnt(4)" ::: "memory"); else asm volatile("s_waitcnt vmcnt(0)" ::: "memory"); \
        asm volatile("s_waitcnt lgkmcnt(0)" ::: "memory"); \
        __builtin_amdgcn_s_barrier(); \
        if (nn_ + 3 < 32) issue(nn_ + 3); \
        __builtin_amdgcn_sched_barrier(0); } while (0)
    bf16x8 qf[8];
#pragma unroll
    for (int ks = 0; ks < 8; ++ks) qf[ks] = *(const bf16x8*)(Qz + (size_t)t * ZC + ks * 32 + q * 8);
    asm volatile("" :: "v"(qf[0]), "v"(qf[1]), "v"(qf[2]), "v"(qf[3]), "v"(qf[4]), "v"(qf[5]), "v"(qf[6]), "v"(qf[7]));
#pragma unroll 1
    for (int h = 0; h < 4; ++h) {
        int rbl = rb, xsl = xs, ql = q;
        asm volatile("" : "+v"(rbl), "+v"(xsl), "+v"(ql));
        f32x4 S[16];
#pragma unroll
        for (int jj = 0; jj < 16; ++jj) S[jj] = (f32x4){0.f, 0.f, 0.f, 0.f};
#pragma unroll
        for (int kt = 0; kt < 4; ++kt) {
            const int n = h * 8 + kt;
            ATT_TOP(n, 0);
            ldsp base = lds + kt * 32768 + rbl;
            bf16x8 f[32];
#define ATT_RD_S(j_) do { f[j_] = *(LAS bf16x8*)(base + ((((((j_) >> 4) * 4 + ql) ^ xsl) & 7) * 16) + (((j_) >> 3) & 1) * 16384 + ((j_) & 7) * 2048); } while (0)
#define ATT_MM_S(i_) do { S[(((i_) >> 3) & 1) * 8 + ((i_) & 7)] = __builtin_amdgcn_mfma_f32_16x16x32_bf16(f[i_], qf[kt * 2 + ((i_) >> 4)], S[(((i_) >> 3) & 1) * 8 + ((i_) & 7)], 0, 0, 0); } while (0)
#pragma unroll
            for (int j = 0; j < ATT_LA; ++j) ATT_RD_S(j);
#pragma unroll
            for (int i = 0; i < 32; ++i) { ATT_MM_S(i); if (i + ATT_LA < 32) ATT_RD_S(i + ATT_LA); }
            ATT_SCHED();
#undef ATT_RD_S
#undef ATT_MM_S
        }
        float mx = -3.0e38f;
#pragma unroll
        for (int jj = 0; jj < 16; ++jj)
#pragma unroll
            for (int r = 0; r < 4; ++r) { S[jj][r] *= 0.0625f; mx = fmaxf(mx, S[jj][r]); }
        mx = fmaxf(mx, __shfl_xor(mx, 16)); mx = fmaxf(mx, __shfl_xor(mx, 32));
        float sm = 0.f;
#pragma unroll
        for (int jj = 0; jj < 16; ++jj)
#pragma unroll
            for (int r = 0; r < 4; ++r) { S[jj][r] = __expf(S[jj][r] - mx); sm += S[jj][r]; }
        sm += __shfl_xor(sm, 16); sm += __shfl_xor(sm, 32);
        const float inv = rcp_(sm);
        u32x4 pk[8];
#pragma unroll
        for (int kk2 = 0; kk2 < 8; ++kk2) {
            pk[kk2][0] = pack2(S[2 * kk2][0] * inv, S[2 * kk2][1] * inv); pk[kk2][1] = pack2(S[2 * kk2][2] * inv, S[2 * kk2][3] * inv);
            pk[kk2][2] = pack2(S[2 * kk2 + 1][0] * inv, S[2 * kk2 + 1][1] * inv); pk[kk2][3] = pack2(S[2 * kk2 + 1][2] * inv, S[2 * kk2 + 1][3] * inv);
        }
        f32x4 Oa[16];
#pragma unroll
        for (int ii = 0; ii < 16; ++ii) Oa[ii] = (f32x4){0.f, 0.f, 0.f, 0.f};
        bf16x8 qn[8];
        {
            const int hn = (h + 1) & 3;
#pragma unroll
            for (int ks = 0; ks < 8; ++ks) qn[ks] = *(const bf16x8*)(Qz + (size_t)t * ZC + hn * 256 + ks * 32 + q * 8);
        }
#pragma unroll
        for (int vs = 0; vs < 4; ++vs) {
            const int n = h * 8 + 4 + vs;
            ATT_TOP(n, vs < 3);
            ldsp base = lds + vs * 32768 + rbl;
            u32x4 f[32];
#define ATT_RD_V(j_) do { f[j_] = *(LAS u32x4*)(base + ((((4 * ((j_) >> 4) + ql) ^ xsl) & 7) << 4) + (((j_) >> 3) & 1) * 16384 + ((j_) & 7) * 2048); } while (0)
#define ATT_MM_V(i_) do { Oa[(((i_) >> 3) & 1) * 8 + ((i_) & 7)] = __builtin_amdgcn_mfma_f32_16x16x32_bf16(__builtin_bit_cast(bf16x8, f[i_]), __builtin_bit_cast(bf16x8, pk[vs * 2 + ((i_) >> 4)]), Oa[(((i_) >> 3) & 1) * 8 + ((i_) & 7)], 0, 0, 0); } while (0)
#pragma unroll
            for (int j = 0; j < ATT_LA; ++j) ATT_RD_V(j);
#pragma unroll
            for (int i = 0; i < 32; ++i) { ATT_MM_V(i); if (i + ATT_LA < 32) ATT_RD_V(i + ATT_LA); }
            ATT_SCHED();
#undef ATT_RD_V
#undef ATT_MM_V
        }
#pragma unroll
        for (int m = 0; m < 8; ++m) {
            const unsigned a0 = pack2(Oa[2 * m][0], Oa[2 * m][1]), a1 = pack2(Oa[2 * m][2], Oa[2 * m][3]);
            const unsigned b0 = pack2(Oa[2 * m + 1][0], Oa[2 * m + 1][1]), b1 = pack2(Oa[2 * m + 1][2], Oa[2 * m + 1][3]);
            const bool odd = q & 1;
            const unsigned r0 = (unsigned)__shfl_xor((int)(odd ? a0 : b0), 16), r1 = (unsigned)__shfl_xor((int)(odd ? a1 : b1), 16);
            u32x4 o;
            o[0] = odd ? r0 : a0; o[1] = odd ? r1 : a1; o[2] = odd ? b0 : r0; o[3] = odd ? b1 : r1;
            *(u32x4*)(Oz + (size_t)t * ZC + h * 256 + (2 * m + (q & 1)) * 16 + 4 * (q & 2)) = o;
        }
        asm volatile("" :: "v"(qn[0]), "v"(qn[1]), "v"(qn[2]), "v"(qn[3]), "v"(qn[4]), "v"(qn[5]), "v"(qn[6]), "v"(qn[7]));
#pragma unroll
        for (int ks = 0; ks < 8; ++ks) qf[ks] = qn[ks];
    }
#undef ATT_TOP
#undef ATT_SCHED
#undef ATT_LA
#undef ATT_SG8
#undef ATT_SG1
}

__device__ void phase_e(const Params& p, int l, ldsp lds, const XcdBarrier& bar, int erep) {
    const bool xwr = (PROBE & 524288) ? (erep == 1) : true;
    const int bid = bid_opaque(), G = gridDim.x;
    float* x = p.out;
    LAS float* rsl = (LAS float*)(lds + LDS_RSL);
    LAS float* ssq = (LAS float*)(lds + L_SSQ);
    enum { OP_GLU = 0, OP_XADD, OP_RS, OP_SOFTMAX, OP_STORE, OP_Z, OP_TOPK };
    const int nsteps = (l + 1 < NL) ? 25 : 20;
#pragma unroll 1
    for (int rt = bid; rt < 256; rt += G) {
        const int row0 = rt * 128, b = rt >> 6;
#pragma unroll 1
        for (int stepi = 0, pdup = 0; stepi < nsteps; ) {
            const int step = stepi;
            if ((PROBE & 131072) && step >= 5 && step <= 12 && pdup == 0) pdup = 1; else if ((PROBE & 262144) && step == 0 && pdup == 0) pdup = 1; else { pdup = 0; ++stepi; }
            int tid = threadIdx.x;
            asm volatile("" : "+v"(tid));
            if (step >= 6 && step < 13) continue;
            const int lane = tid & 63, wave = __builtin_amdgcn_readfirstlane(tid >> 6);
            unsigned char* wsl = ptr_opaque(p.ws);
            unsigned char* W = wsl + WS_WT + (size_t)l * WT_LAYER;
            const unsigned char* W8 = wsl + WS_W8 + (size_t)l * W8_LAYER;
            unsigned char* xqr = wsl + WS_XQ + (size_t)row0 * 1024;
            const float* SW = (const float*)(W + WO_SW);
            LAS float* sxl = (LAS float*)(lds + L_SXL);
            bf16_t* zb = (bf16_t*)(wsl + WS_Z);
            bf16_t* ymix = (bf16_t*)(wsl + WS_YMIX);
            bf16_t* zr = zb + (size_t)row0 * ZC;
            unsigned char* scr = wsl + WS_SCR + (size_t)bid * SCR_BLK;
            bf16_t* Psc = (bf16_t*)(scr);
            unsigned* SEL = (unsigned*)(scr + 65536);
            unsigned char* aq = scr + 65536;
            if (step == 19) {
#pragma unroll 1
                for (int e7rep = 0; e7rep < ((PROBE & 65536) ? 2 : 1); ++e7rep)
                if (ESUB & 1) {
                    if (e7rep) block_gsync();
                    LAS float* SC = (LAS float*)lds;
                    LAS int* PL = (LAS int*)(lds + 66048);
                    int* FIN = (int*)(scr + 196608);
                    const bf16_t* keys = (const bf16_t*)(W + WO_KEYS);
                    block_gsync();
                    {
                        LAS int* LK = (LAS int*)(lds + wave * 8192);
                        const int hd = wave;
#pragma unroll 1
                        for (int th = 0; th < 2; ++th) {
                            const int t = th * 64 + lane;
                            float f1[16], f2[16];
#pragma unroll
                            for (int i = 0; i < 16; ++i) {
                                const int u1 = key2u(FIN[((hd * 2) * 16 + i) * 128 + t]), u2 = key2u(FIN[((hd * 2 + 1) * 16 + i) * 128 + t]);
                                const float rt_ = rsl[t] * sxl[t];
                                f1[i] = __int_as_float(u1) * rt_; f2[i] = __int_as_float(u2) * rt_;
                                LK[i * 64 + lane] = u1 & 127; LK[(16 + i) * 64 + lane] = u2 & 127;
                            }
                            int g0[16], g1[16], g2[16], g3[16];
                            {
                                int n = 0;
#pragma unroll
                                for (int a = 0; a < 16; ++a)
#pragma unroll
                                    for (int b2 = 0; b2 < 16; ++b2)
                                        if ((a + 1) * (b2 + 1) <= 16) {
                                            const int k = f2key(f1[a] + f2[b2], a * 16 + b2, 255);
                                            if (n < 16) g0[n] = k; else if (n < 32) g1[n - 16] = k; else if (n < 48) g2[n - 32] = k; else g3[n - 48] = k;
                                            ++n;
                                        }
#pragma unroll
                                for (int i = 2; i < 16; ++i) g3[i] = (int)0x80000000;
                            }
                            sort16_desc(g0); sort16_desc(g1); sort16_desc(g2); sort16_desc(g3);
                            merge16_desc(g0, g1); merge16_desc(g2, g3); merge16_desc(g0, g2);
                            asm volatile("s_waitcnt lgkmcnt(0)" ::: "memory");
                            float val[16]; float sm = 0.f;
                            const float mx = __int_as_float(key2u(g0[0]));
#pragma unroll
                            for (int i = 0; i < 16; ++i) { val[i] = __expf(__int_as_float(key2u(g0[i])) - mx); sm += val[i]; }
                            const float inv = rcp_(sm);
#pragma unroll
                            for (int i = 0; i < 16; ++i) {
                                const int code = key2u(g0[i]) & 255;
                                const int eid = LK[(code >> 4) * 64 + lane] * 128 + LK[(16 + (code & 15)) * 64 + lane];
                                const float su_e = ((const float*)(W + WO_SU))[eid], sv_e = ((const float*)(W + WO_SV))[eid];
                                uint2 o; o.x = (unsigned)eid | ((unsigned)f2bf(su_e) << 16); o.y = __float_as_uint(val[i] * inv * sv_e);
                                *(uint2*)(SEL + ((size_t)(t * 8 + hd) * 16 + i) * 2) = o;
                            }
                            asm volatile("s_waitcnt lgkmcnt(0)" ::: "memory");
                        }
                    }
                }
                block_gsync();
                if (ESUB & 2) {
                    const unsigned char* ub8 = wsl + WS_UB + (size_t)l * 16384 * 1024;
                    const unsigned char* vb8 = wsl + WS_VB + (size_t)l * 16384 * 1024;
                    float* rsg = (float*)(wsl + WS_RS); float* sxg = (float*)(wsl + WS_SX);
                    const float* gfin = p.in[I_NFIN];
                    unsigned* SP = (unsigned*)(scr + 196608);
                    float* COEF = (float*)(scr + 196608 + 65536);
                    LAS unsigned* hist = (LAS unsigned*)(lds + 133120);
                    const int q = lane >> 4, n = lane & 15;
#pragma unroll 1
                    for (int srep = 0; srep < ((PROBE & 2097152) ? 2 : 1); ++srep) {
                    if (srep) block_gsync();
                    if (tid < 128) hist[tid] = 0u;
#pragma unroll 1
                    for (int ch0 = tid; ch0 < 8192; ch0 += 8 * NTHREADS) {
                        u32x4 cv[8];
#pragma unroll
                        for (int u = 0; u < 8; ++u) { const int ch = ch0 + u * NTHREADS; cv[u] = *(const u32x4*)(xqr + (size_t)(ch >> 6) * 1024 + (ch & 63) * 16); }
#pragma unroll
                        for (int u = 0; u < 8; ++u) { const int ch = ch0 + u * NTHREADS; *(LAS u32x4*)(lds + (ch >> 6) * 1040 + (ch & 63) * 16) = cv[u]; }
                    }
                    __syncthreads();
                    unsigned keys[32];
#pragma unroll
                    for (int j = 0; j < 32; ++j) {
                        const unsigned i = (unsigned)tid + 512u * j;
                        const unsigned eid = SEL[(size_t)i * 2] & 0xffffu;
                        keys[j] = (eid << 14) | i;
                        __hip_atomic_fetch_add(&hist[eid >> 7], 1u, __ATOMIC_RELAXED, __HIP_MEMORY_SCOPE_WORKGROUP);
                    }
                    __syncthreads();
                    if (wave == 0) {
                        const unsigned c0 = hist[2 * lane], c1 = hist[2 * lane + 1];
                        unsigned inc = c0 + c1;
#pragma unroll
                        for (int o = 1; o < 64; o <<= 1) { const unsigned t_ = (unsigned)__shfl_up((int)inc, o); if (lane >= o) inc += t_; }
                        const unsigned exc = inc - (c0 + c1);
                        hist[2 * lane] = exc; hist[2 * lane + 1] = exc + c0;
                    }
                    __syncthreads();
#pragma unroll
                    for (int j = 0; j < 32; ++j) {
                        const unsigned pos = __hip_atomic_fetch_add(&hist[keys[j] >> 21], 1u, __ATOMIC_RELAXED, __HIP_MEMORY_SCOPE_WORKGROUP);
                        SP[pos] = keys[j];
                    }
                    }
                    block_gsync();
                    if (G == 256) xcd_barrier(bar);
                    {
                        unsigned k4n = SP[wave * 64 + lane];
#pragma unroll 1
                        for (int it = 0; it < 32; ++it) {
                            const unsigned k4 = k4n;
                            if (it + 1 < 32) k4n = SP[(wave + 8 * (it + 1)) * 64 + lane];
                            const uint2 se = *(const uint2*)(SEL + ((size_t)((k4 >> 7) & 127u) * 128 + (k4 & 127u)) * 2);
                            u32x4 ur[4][4];
                            unsigned keyr[4];
#pragma unroll
                            for (int t = 0; t < 4; ++t) {
                                keyr[t] = (unsigned)__shfl((int)k4, (lane & 48) + t);
                                const unsigned char* up = ub8 + (size_t)(keyr[t] >> 14) * 1024 + n * 16;
#pragma unroll
                                for (int c = 0; c < 4; ++c) ur[t][c] = *(const u32x4*)(up + c * 256);
                            }
                            int dvec = 0;
#pragma unroll
                            for (int t = 0; t < 16; ++t) {
                                const int tok = (int)((keyr[t & 3] >> 7) & 127u);
                                ldsp xr = lds + tok * 1040 + n * 16;
                                u32x4 xv[4];
#pragma unroll
                                for (int c = 0; c < 4; ++c) xv[c] = *(LAS u32x4*)(xr + c * 256);
                                __builtin_amdgcn_sched_group_barrier(0x100, 4, 0);
                                int sc4[4] = {0, 0, 0, 0};
#pragma unroll
                                for (int e = 0; e < 4; ++e)
#pragma unroll
                                    for (int c = 0; c < 4; ++c) sc4[c] = __builtin_amdgcn_sdot4((int)ur[t & 3][c][e], (int)xv[c][e], sc4[c], false);
                                int sacc = (sc4[0] + sc4[1]) + (sc4[2] + sc4[3]);
                                if (t + 4 < 16) {
                                    keyr[t & 3] = (unsigned)__shfl((int)k4, (lane & 48) + t + 4);
                                    const unsigned char* up = ub8 + (size_t)(keyr[t & 3] >> 14) * 1024 + n * 16;
#pragma unroll
                                    for (int c = 0; c < 4; ++c) ur[t & 3][c] = *(const u32x4*)(up + c * 256);
                                }
                                sacc = row16_sum_i(sacc);
                                if (n == t) dvec = sacc;
                            }
                            {
                                const int tok = (int)((k4 >> 7) & 127u), slot = (int)(k4 & 127u);
                                COEF[tok * 128 + slot] = __uint_as_float(se.y) * gelu_((float)dvec * bfhi(se.x) * sxl[tok] * rsl[tok]);
                            }
                        }
                    }
                    block_gsync();
                    {
                        LAS float* SSQ2 = (LAS float*)(lds + 133632); LAS float* AMX = (LAS float*)(lds + 134144);
                        LAS float* SCL = (LAS float*)(lds + 134656); LAS int* CSI = (LAS int*)(lds + 135168);
                        using u2 = __attribute__((ext_vector_type(2))) unsigned;
                        typedef short s16x2 __attribute__((ext_vector_type(2)));
#pragma unroll 1
                        for (int i4 = 0; i4 < 16; i4 += 4) {
                          float2 c01v[4]; uint4 sev[4];
#pragma unroll
                          for (int u = 0; u < 4; ++u) { c01v[u] = *(const float2*)(COEF + (wave * 16 + i4 + u) * 128 + 2 * lane); sev[u] = *(const uint4*)(SEL + ((size_t)(wave * 16 + i4 + u) * 128 + 2 * lane) * 2); }
#pragma unroll
                          for (int u = 0; u < 4; ++u) {
                            const int rr = wave * 16 + i4 + u;
                            const float2 c01 = c01v[u];
                            const uint4 se = sev[u];
                            const float cmax = wave_max(fmaxf(fabsf(c01.x), fabsf(c01.y)));
                            const float sc = cmax > 0.f ? 127.0f / cmax : 0.f;
                            const int q0 = (int)rintf(c01.x * sc), q1 = (int)rintf(c01.y * sc);
                            const unsigned cw = ((unsigned)q0 & 255u) | (((unsigned)q1 & 255u) << 8);
                            const unsigned ew = (se.x & 0xffffu) | (se.z << 16);
                            const unsigned cwn = (unsigned)dppi<0xB1>((int)cw), ewn = (unsigned)dppi<0xB1>((int)ew);
                            if ((lane & 1) == 0) {
                                u32x4 e; e[0] = (ew & 0xffffu) << 7; e[1] = (ew >> 16) << 7; e[2] = (ewn & 0xffffu) << 7; e[3] = (ewn >> 16) << 7;
                                *(LAS u32x4*)(lds + rr * 1040 + (lane >> 1) * 32) = e;
                                *(LAS unsigned*)(lds + rr * 1040 + (lane >> 1) * 32 + 16) = cw | (cwn << 16);
                            }
                            if (lane == 0) SCL[rr] = cmax * (1.0f / 127.0f);
                          }
                        }
                        __syncthreads();
                        const int tl = lane >> 3, cc = lane & 7;
#define P2_LOAD(V, C, base) _Pragma("unroll") for (int u = 0; u < 2; ++u) { u32x4 e = *(LAS u32x4*)(pr + ((base) + u) * 32); C[u] = *(LAS unsigned*)(pr + ((base) + u) * 32 + 16); \
                                if ((PROBE & 8192) && prep == 0) { e[0] &= 0x3f80u; e[1] &= 0x3f80u; e[2] &= 0x3f80u; e[3] &= 0x3f80u; } \
                                V[4 * u] = *(const u32x4*)(vk + (e[0] | ccoff)); V[4 * u + 1] = *(const u32x4*)(vk + (e[1] | ccoff)); \
                                V[4 * u + 2] = *(const u32x4*)(vk + (e[2] | ccoff)); V[4 * u + 3] = *(const u32x4*)(vk + (e[3] | ccoff)); }
#define P2_COMP(V, C) _Pragma("unroll") for (int u = 0; u < 2; ++u) { const int c4 = (int)C[u]; \
                                _Pragma("unroll") for (int i = 0; i < 4; ++i) { const unsigned wa = V[4 * u][i], wb = V[4 * u + 1][i], wc = V[4 * u + 2][i], wd = V[4 * u + 3][i]; \
                                    const unsigned pp = __builtin_amdgcn_perm(wb, wa, 0x05010400u), qq = __builtin_amdgcn_perm(wb, wa, 0x07030602u); \
                                    const unsigned rr_ = __builtin_amdgcn_perm(wd, wc, 0x05010400u), ss = __builtin_amdgcn_perm(wd, wc, 0x07030602u); \
                                    acc[4 * i]     = __builtin_amdgcn_sdot4((int)__builtin_amdgcn_perm(rr_, pp, 0x05040100u), c4, acc[4 * i], false); \
                                    acc[4 * i + 1] = __builtin_amdgcn_sdot4((int)__builtin_amdgcn_perm(rr_, pp, 0x07060302u), c4, acc[4 * i + 1], false); \
                                    acc[4 * i + 2] = __builtin_amdgcn_sdot4((int)__builtin_amdgcn_perm(ss, qq, 0x05040100u), c4, acc[4 * i + 2], false); \
                                    acc[4 * i + 3] = __builtin_amdgcn_sdot4((int)__builtin_amdgcn_perm(ss, qq, 0x07060302u), c4, acc[4 * i + 3], false); } }
#pragma unroll 1
                        for (int prep = 0; prep < ((PROBE & 4096) ? 2 : 1); ++prep)
#pragma unroll 1
                        for (int k = 0; k < 8; ++k) {
                            const unsigned char* vk = vb8 + (size_t)k * (16384 * 128);
                            const unsigned ccoff = (unsigned)cc * 16u;
#pragma unroll 1
                            for (int ps = 0; ps < 2; ++ps) {
                                const int rr = wave * 16 + ps * 8 + tl;
                                ldsp pr = lds + rr * 1040;
                                int acc[16];
#pragma unroll
                                for (int i = 0; i < 16; ++i) acc[i] = 0;
                                u32x4 va[8], vb_[8]; unsigned ca[2], cb[2];
                                P2_LOAD(va, ca, 0)
#pragma unroll 1
                                for (int j = 0; j < 32; j += 4) {
                                    P2_LOAD(vb_, cb, j + 2)
                                    P2_COMP(va, ca)
                                    if (j + 4 < 32) { P2_LOAD(va, ca, j + 4) }
                                    P2_COMP(vb_, cb)
                                }
                                const float scl = SCL[rr]; const int off = 0;
                                float4* xp = (float4*)(x + (size_t)(row0 + rr) * DM + k * 128 + cc * 16);
                                float ss = 0.f, am = 0.f;
#pragma unroll
                                for (int i = 0; i < 4; ++i) {
                                    float4 h4 = xp[i];
                                    h4.x += (float)(acc[4 * i] - off) * scl; h4.y += (float)(acc[4 * i + 1] - off) * scl; h4.z += (float)(acc[4 * i + 2] - off) * scl; h4.w += (float)(acc[4 * i + 3] - off) * scl;
                                    if ((!(PROBE & 4096) || prep == 1) && xwr) xp[i] = h4;
                                    ss += h4.x * h4.x + h4.y * h4.y + h4.z * h4.z + h4.w * h4.w;
                                    am = fmaxf(am, fmaxf(fmaxf(fabsf(h4.x), fabsf(h4.y)), fmaxf(fabsf(h4.z), fabsf(h4.w))));
                                }
                                ss = grp8_sum(ss);
                                am = fmaxf(am, dppf<0xB1>(am)); am = fmaxf(am, dppf<0x4E>(am)); am = fmaxf(am, dppf<0x141>(am));
                                if (cc == 0 && (!(PROBE & 4096) || prep == 1)) { SSQ2[rr] = (k == 0 ? 0.f : SSQ2[rr]) + ss; AMX[rr] = fmaxf(k == 0 ? 0.f : AMX[rr], am); }
                            }
                        }
                        asm volatile("s_waitcnt vmcnt(0) lgkmcnt(0)" ::: "memory");
#pragma unroll 1
                        for (int i4 = 0; i4 < 16; i4 += 4) {
                          float4 xv4[4][4];
#pragma unroll
                          for (int u = 0; u < 4; ++u)
#pragma unroll
                              for (int j = 0; j < 4; ++j) xv4[u][j] = ((const float4*)(x + (size_t)(row0 + wave * 16 + i4 + u) * DM + lane * 16))[j];
#pragma unroll
                          for (int u = 0; u < 4; ++u) {
                            const int rr = wave * 16 + i4 + u, row = row0 + rr;
                            const float rn = __builtin_amdgcn_rsqf(SSQ2[rr] * (1.0f / DM) + RMS_EPS);
                            float hx[16];
#pragma unroll
                            for (int j = 0; j < 4; ++j) { hx[4 * j] = xv4[u][j].x; hx[4 * j + 1] = xv4[u][j].y; hx[4 * j + 2] = xv4[u][j].z; hx[4 * j + 3] = xv4[u][j].w; }
                            if (l == NL - 1) {
                                float4* xw = (float4*)(x + (size_t)row * DM + lane * 16);
                                const float4* gp = (const float4*)(gfin + lane * 16);
#pragma unroll
                                for (int j = 0; j < 4; ++j) { const float4 g4 = gp[j]; if (xwr) xw[j] = make_float4(hx[4 * j] * rn * g4.x, hx[4 * j + 1] * rn * g4.y, hx[4 * j + 2] * rn * g4.z, hx[4 * j + 3] * rn * g4.w); }
                            } else {
                                const float am2 = AMX[rr];
                                *(u32x4*)(xqr + (size_t)rr * 1024 + lane * 16) = q16(hx, am2 > 0.f ? 127.0f / am2 : 0.f);
                                if (lane == 0) { rsg[row] = rn; sxg[row] = am2 * (1.0f / 127.0f); rsl[rr] = rn; sxl[rr] = am2 * (1.0f / 127.0f); }
                            }
                          }
                        }
                    }
                }
                block_gsync();
                continue;
            }
            const unsigned char* A; const unsigned char* Bt; int lda, ldb, KB, op, sub, kst = 64; bool wide = true, i8 = true; const float* sw = SW;
            if (step < 1)       { sub = 0;         op = OP_GLU;  i8 = false; A = (const unsigned char*)(ymix + (size_t)row0 * DM + 512); lda = 2048; Bt = W + WO_GLU; ldb = 1024; KB = 1024; }
            else if (step < 3)  { sub = step - 1;  op = OP_XADD; i8 = false; A = (const unsigned char*)(ymix + (size_t)row0 * DM); lda = 2048; Bt = W + WO_WOUT + (size_t)sub * 512 * 2048; ldb = 2048; KB = 2048; }
            else if (step < 5)  { sub = step - 3;  op = OP_RS;   A = xqr; lda = 1024; Bt = W8 + W8_WQ + (size_t)sub * 524288; ldb = 64; kst = 32768; KB = 1024; sw = SW + SW_WQ; }
            else if (step < 13) {
                sub = (step - 5) >> 1; wide = false; i8 = false;
                if (((step - 5) & 1) == 0) { op = OP_SOFTMAX; A = (const unsigned char*)(zr + sub * 256); lda = ZC * 2; Bt = wsl + WS_KMEM + ((size_t)l * 1024 * 1024 + (size_t)(b * 256) * 1024 + sub * 256) * 2; ldb = 2048; KB = 512; }
                else { op = OP_STORE; A = (const unsigned char*)Psc; lda = 512; Bt = wsl + WS_VMEMT + ((size_t)l * 1024 * 1024 + (size_t)(sub * 256) * 1024 + b * 256) * 2; ldb = 2048; KB = 512; }
            }
            else if (step < 15) { sub = step - 13; op = OP_XADD; A = aq; lda = 1024; Bt = W8 + W8_WO + (size_t)sub * 524288; ldb = 64; kst = 32768; KB = 1024; sw = SW + SW_WO; }
            else if (step < 19) { sub = step - 15; op = OP_TOPK; A = xqr; lda = 1024; Bt = W8 + W8_WPQ + (size_t)sub * 524288; ldb = 64; kst = 32768; KB = 1024; sw = SW + SW_WPQ; }
            else                { sub = step - 20; op = OP_Z;    A = xqr; lda = 1024; Bt = wsl + WS_W8 + (size_t)(l + 1) * W8_LAYER + W8_WIN + (size_t)sub * 524288; ldb = 64; kst = 32768; KB = 1024;
                                  sw = (const float*)(wsl + WS_WT + (size_t)(l + 1) * WT_LAYER + WO_SW) + SW_WIN; }
            if (step == 0) { if (tid < 128) ssq[tid] = 0.f; __syncthreads(); }
            if (step == 13) { quant_rows_bf16(zr + 1024, ZC, aq, lds, lane, wave); block_gsync(); }
            if (wide && i8) {
                i32x16 acc5[2][4];
#pragma unroll 1
                for (int prep_ = 0; prep_ < ((PROBE & 16384) ? 2 : 1); ++prep_)
                gemm512_acc<true>(A, lda, Bt, ldb, kst, KB, lds, acc5);
#pragma unroll 1
                for (int h = 0; h < 2; ++h) {
                    const int col0 = sub * 512 + h * 256;
                    LAS float* SWL = (LAS float*)(lds + 134656);
                    if (op == OP_TOPK && tid < 256) SWL[tid] = sw[col0 + tid];
                    gemm512_store_half(acc5, h, lds);
                    if (op == OP_XADD) {
                        xadd_rowpass_i(lds, x, sw, row0, col0, lane, wave, xwr);
                    } else if (op == OP_TOPK) {
                        const int t = tid >> 2, hc2 = (tid >> 1) & 1, hf = tid & 1, rot = (tid & 3) * 16;
                        LAS int* TI = (LAS int*)lds;
                        const int cb = hc2 * 128 + hf * 64;
                        int sa_[16], sb_[16];
#pragma unroll
                        for (int i = 0; i < 16; ++i) { const int k0 = (i + rot) & 63; sa_[i] = f2key((float)TI[t * 260 + cb + k0] * SWL[cb + k0], hf * 64 + k0, 127); }
                        sort16_desc(sa_);
#pragma unroll 1
                        for (int g4 = 1; g4 < 4; ++g4) {
#pragma unroll
                            for (int i = 0; i < 16; ++i) { const int k1 = (g4 * 16 + i + rot) & 63; sb_[i] = f2key((float)TI[t * 260 + cb + k1] * SWL[cb + k1], hf * 64 + k1, 127); }
                            sort16_desc(sb_); merge16_desc(sa_, sb_);
                        }
#pragma unroll
                        for (int i = 0; i < 16; ++i) sb_[i] = dppi<0xB1>(sa_[i]);
                        merge16_desc(sa_, sb_);
                        int* FINw = (int*)(scr + 196608);
                        const int hcg = sub * 4 + h * 2 + hc2;
#pragma unroll
                        for (int j = 0; j < 8; ++j) FINw[(hcg * 16 + hf * 8 + j) * 128 + t] = sa_[j] ^ ((sa_[j] ^ sa_[8 + j]) & -hf);
                    } else if (op == OP_RS) {
                        const float4 w4 = *(const float4*)(sw + col0 + lane * 4);
                        TILE_ROWS4(r0) {
                            f32x4 v[4]; float r[4];
#pragma unroll
                            for (int u = 0; u < 4; ++u) { v[u] = tile4i(lds, r0 + 8 * u, lane); r[u] = rsl[r0 + 8 * u] * sxl[r0 + 8 * u]; }
                            __builtin_amdgcn_sched_group_barrier(0x100, 12, 0);
#pragma unroll
                            for (int u = 0; u < 4; ++u) st_bf4(zr + (size_t)(r0 + 8 * u) * ZC + col0 + lane * 4, v[u][0] * r[u] * w4.x, v[u][1] * r[u] * w4.y, v[u][2] * r[u] * w4.z, v[u][3] * r[u] * w4.w);
                        }
                    } else {
                        z_rowpass(lds, zb, [&](int rr) { return rsl[rr] * sxl[rr]; }, sw, row0, col0, ZN1, lane, wave);
                    }
                    __syncthreads();
                }
            } else if (wide) {
                f32x16 acc5[2][4];
                gemm512_acc<false>(A, lda, Bt, ldb, kst, KB, lds, acc5);
#pragma unroll 1
                for (int h = 0; h < 2; ++h) {
                    gemm512_store_half(acc5, h, lds);
                    const int col0 = sub * 512 + h * 256;
                    if (op == OP_GLU) {
                        const float4 bias = *(const float4*)(p.in[I_GLUB] + l * 512 + col0 + lane * 4);
                        TILE_ROWS4(r0) {
                          f32x4 v4_[4]; uint2 yv4[4];
#pragma unroll
                          for (int u = 0; u < 4; ++u) { v4_[u] = tile4(lds, r0 + 8 * u, lane); yv4[u] = *(const uint2*)(ymix + (size_t)(row0 + r0 + 8 * u) * DM + 512 + col0 + lane * 4); }
#pragma unroll
                          for (int u = 0; u < 4; ++u) {
                            const int rr = r0 + 8 * u;
                            const f32x4 v = v4_[u];
                            const uint2 yv = yv4[u];
                            const float y0 = bflo(yv.x) * sigmoidf_(v[0] + bias.x), y1 = bfhi(yv.x) * sigmoidf_(v[1] + bias.y);
                            const float y2 = bflo(yv.y) * sigmoidf_(v[2] + bias.z), y3 = bfhi(yv.y) * sigmoidf_(v[3] + bias.w);
                            st_bf4(zr + (size_t)rr * ZC + col0 + lane * 4, y0, y1, y2, y3);
                            const float s = wave_sum(y0 * y0 + y1 * y1 + y2 * y2 + y3 * y3);
                            if (lane == 0) ssq[rr] += s;
                          }
                        }
                    } else {
                        xadd_rowpass_f(lds, x, (l == 0 && G == 256) ? p.in[I_X] : x, row0, col0, lane, wave, xwr);
                    }
                    __syncthreads();
                }
            } else if (op == OP_SOFTMAX) {
                attn_all(zr, (const bf16_t*)(wsl + WS_KMEM) + (size_t)l * 1024 * 1024 + (size_t)b * 262144, (const bf16_t*)(wsl + WS_VMEMT) + (size_t)l * 1024 * 1024 + (size_t)b * 262144, zr + 1024, lds);
            } else {
                gemm_to_lds<256>((const bf16_t*)A, lda >> 1, (const bf16_t*)Bt, ldb >> 1, KB >> 1, lds);
                if (op == OP_SOFTMAX) {
                    TILE_ROWS(rr) {
                        const f32x4 sv = tile4(lds, rr, lane);
                        const float s0 = sv[0] * 0.0625f, s1 = sv[1] * 0.0625f, s2 = sv[2] * 0.0625f, s3 = sv[3] * 0.0625f;
                        const float m = wave_max(fmaxf(fmaxf(s0, s1), fmaxf(s2, s3)));
                        const float e0 = __expf(s0 - m), e1 = __expf(s1 - m), e2 = __expf(s2 - m), e3 = __expf(s3 - m);
                        const float inv = rcp_(wave_sum(e0 + e1 + e2 + e3));
                        st_bf4(Psc + rr * 256 + lane * 4, e0 * inv, e1 * inv, e2 * inv, e3 * inv);
                    }
                } else {
                    TILE_ROWS(rr) { const f32x4 v = tile4(lds, rr, lane); st_bf4(zr + (size_t)rr * ZC + 1024 + sub * 256 + lane * 4, v[0], v[1], v[2], v[3]); }
                }
            }
            if (!wide || step == 0 || step == 2 || step == 4 || step == 14 || step == 18) block_gsync();
            if (step == 0) {
                const float* og = p.in[I_S5OG] + l * 512 + lane * 8;
                const float4 g0 = *(const float4*)og, g1 = *(const float4*)(og + 4);
                TILE_ROWS4(r0) {
                  uint4 yv4[4];
#pragma unroll
                  for (int u = 0; u < 4; ++u) yv4[u] = *(const uint4*)(zr + (size_t)(r0 + 8 * u) * ZC + lane * 8);
#pragma unroll
                  for (int u = 0; u < 4; ++u) {
                    const int rr = r0 + 8 * u;
                    const uint4 yv = yv4[u];
                    const float r = __builtin_amdgcn_rsqf(ssq[rr] * (1.0f / 512.f) + RMS_EPS);
                    uint4 o;
                    o.x = pack2(bflo(yv.x) * r * g0.x, bfhi(yv.x) * r * g0.y); o.y = pack2(bflo(yv.y) * r * g0.z, bfhi(yv.y) * r * g0.w);
                    o.z = pack2(bflo(yv.z) * r * g1.x, bfhi(yv.z) * r * g1.y); o.w = pack2(bflo(yv.w) * r * g1.z, bfhi(yv.w) * r * g1.w);
                    if (xwr) *(uint4*)(ymix + (size_t)(row0 + rr) * DM + 512 + lane * 8) = o;
                  }
                }
                block_gsync();
            }
            if (step == 2 || step == 14) { quant_rows_x(x + (size_t)row0 * DM, xqr, lds, lane, wave); block_gsync(); }
        }
    }
}

__global__ void __launch_bounds__(NTHREADS, 2) fwd_kernel(Params p) {
    extern __shared__ __attribute__((aligned(16))) unsigned char lds_raw[];
    ldsp lds = (ldsp)lds_raw;
    const int tid = threadIdx.x;
    if (__builtin_amdgcn_readfirstlane(threadIdx.x) >= 256) __builtin_amdgcn_s_setprio(1);
    volatile LAS unsigned* st = (volatile LAS unsigned*)(lds + LDS_ST);
    if (tid < 4) st[tid] = 0u;
    __syncthreads();
    XcdBarrier bar = xcd_barrier_post((unsigned*)(p.ws + WS_CTL), st);
#ifndef ONLY
#define ONLY 0xff
#endif
#pragma unroll 1
    for (int rep = 0; rep < ((PROBE & 1) ? 2 : 1); ++rep) { if (ONLY & 1) p0_prep(p, lds); xcd_barrier(bar); }
    p0b_quant_weights(p);
    xcd_barrier(bar);
#pragma unroll 1
    for (int rep = 0; rep < ((PROBE & 2) ? 2 : 1); ++rep) { if (ONLY & 2) phase_a(p, 0, true, lds); xcd_barrier(bar); }
#pragma unroll 1
    for (int l = 0; l < NL; ++l) {
#pragma unroll 1
        for (int rep = 0; rep < ((PROBE & 4) ? 2 : 1); ++rep) { if (ONLY & 4) phase_bd(p, l, 0, lds); xcd_barrier(bar); }
#pragma unroll 1
        for (int crep = 0; crep < ((PROBE & 1048576) ? 2 : 1); ++crep) { if (crep) xcd_barrier(bar);
        if (ONLY & 16) phase_c(p, l, lds, (PROBE & 1048576) ? (crep == 1) : true); }
        xcd_barrier(bar);
#pragma unroll 1
        for (int rep = 0; rep < ((PROBE & 8) ? 2 : 1); ++rep) { if (ONLY & 4) phase_bd(p, l, 1, lds); xcd_barrier(bar); }
#pragma unroll 1
        for (int erep = 0; erep < ((PROBE & 524288) ? 2 : 1); ++erep) { if (erep) xcd_barrier(bar);
        if (ONLY & 8) phase_e(p, l, lds, bar, erep); }
        if (l + 1 < NL) xcd_barrier(bar);
    }
}

extern "C" void kernel_launch(void* const* d_in, const int* in_sizes, int n_in, void* d_out, int out_size,
                              void* d_ws, size_t ws_size, hipStream_t stream) {
    constexpr size_t kDynLds = LDS_TOTAL;
    static int grid = 0;
    if (!grid) {
        int dev = 0, cus = 0, per_cu = 0;
        (void)hipGetDevice(&dev);
        (void)hipDeviceGetAttribute(&cus, hipDeviceAttributeMultiprocessorCount, dev);
        (void)hipFuncSetAttribute((const void*)fwd_kernel, hipFuncAttributeMaxDynamicSharedMemorySize, (int)kDynLds);
        (void)hipOccupancyMaxActiveBlocksPerMultiprocessor(&per_cu, (const void*)fwd_kernel, NTHREADS, kDynLds);
        if (per_cu < 1) { fprintf(stderr, "occupancy query says %d blocks/CU\n", per_cu); per_cu = 1; }
        grid = cus;
        if (grid > 256) grid = 256;
        fprintf(stderr, "kernel_launch: cus=%d per_cu=%d grid=%d ws=%zu need=%zu n_in=%d\n", cus, per_cu, grid, ws_size, (size_t)WS_END, n_in);
    }
    if (ws_size < WS_END || n_in < N_IN) { fprintf(stderr, "workspace too small / bad inputs\n"); return; }
    (void)hipMemsetAsync((char*)d_ws + WS_CTL, 0, XCD_BAR_WORDS * 4, stream);
    Params p{};
    for (int i = 0; i < N_IN; ++i) p.in[i] = (const float*)d_in[i];
    p.out = (float*)d_out; p.ws = (unsigned char*)d_ws; p.ph_lo = 0; p.ph_hi = 100;
    void* args[] = {&p};
    hipError_t e = hipLaunchCooperativeKernel((const void*)fwd_kernel, dim3(grid), dim3(NTHREADS), args, kDynLds, stream);
    if (e != hipSuccess) fprintf(stderr, "cooperative launch failed: %s (grid %d)\n", hipGetErrorString(e), grid);
}
```
